# Optimizing an MI355X kernel written in HIP

```python
import jax, jax.numpy as jnp
from jax import lax
import numpy as np

D_MODEL = 1024
BATCH = 8
SEQ = 8192
DEPTH = 2

N_MEM = 256
D_MIX = D_MODEL
POOL_WIDTH = D_MIX // 2
POOL_WINDOWS = (2, 4, 8, 16)
POOL_GROUPS = len(POOL_WINDOWS)
POOL_GROUP_DIM = POOL_WIDTH // POOL_GROUPS
SGU_WIDTH = D_MIX - POOL_WIDTH
SGU_HEADS = 4
SGU_HEAD_DIM = SGU_WIDTH // SGU_HEADS
CHUNK = 128
D_IN_PROJ = POOL_WIDTH + 2 * SGU_WIDTH
XATTN_HEADS = 4
XATTN_HEAD_DIM = D_MODEL // XATTN_HEADS
D_FF = 2816
CONV_WIDTH = 3
EPS = 1e-6

kernel_name = "hybrid_pool_sgu_memxattn_convffn"


def rmsnorm(x, g):
    xf = x.astype(jnp.float32)
    y = xf * lax.rsqrt(jnp.mean(xf * xf, axis=-1, keepdims=True) + EPS)
    return (y * g.astype(jnp.float32)).astype(x.dtype)


def layernorm_nobias(x, g):
    xf = x.astype(jnp.float32)
    mu = jnp.mean(xf, axis=-1, keepdims=True)
    xc = xf - mu
    y = xc * lax.rsqrt(jnp.mean(xc * xc, axis=-1, keepdims=True) + EPS)
    return (y * g.astype(jnp.float32)).astype(x.dtype)


def pool_mixer(p, pool_w, pool_scale):
    B, S, _ = p.shape
    pf = p.astype(jnp.float32)
    c = jnp.pad(jnp.cumsum(pf, axis=1), ((0, 0), (1, 0), (0, 0)))
    t = jnp.arange(S)
    diffs = []
    for gi, win in enumerate(POOL_WINDOWS):
        sl = slice(gi * POOL_GROUP_DIM, (gi + 1) * POOL_GROUP_DIM)
        cg = c[..., sl]
        prev = jnp.pad(cg, ((0, 0), (win - 1, 0), (0, 0)))[:, :S]
        count = jnp.minimum(t + 1, win).astype(jnp.float32)[None, :, None]
        diffs.append((cg[:, 1:] - prev) / count - pf[..., sl])
    d = jnp.stack(diffs, axis=2).astype(p.dtype)
    y = jnp.einsum('bsgc,gcd->bsgd', d, pool_w).reshape(B, S, POOL_WIDTH)
    return y * pool_scale


def sgu_mixer(u, v, sgu_g, sgu_w, sgu_b):
    B, S, _ = u.shape
    vn = layernorm_nobias(v, sgu_g)
    vc = vn.reshape(B, S // CHUNK, CHUNK, SGU_HEADS, SGU_HEAD_DIM)
    mask = jnp.tril(jnp.ones((CHUNK, CHUNK), dtype=bool))
    w_masked = jnp.where(mask[None], sgu_w, jnp.zeros_like(sgu_w))
    z = jnp.einsum('hts,bnshd->bnthd', w_masked, vc) + sgu_b.T[:, :, None]
    return u * z.reshape(B, S, SGU_WIDTH)


def mem_cross_attention(xn, mem, mem_g, wq, wk, wv, wo):
    B, S, _ = xn.shape
    memn = rmsnorm(mem, mem_g)
    q = (xn @ wq).reshape(B, S, XATTN_HEADS, XATTN_HEAD_DIM)
    k = (memn @ wk).reshape(B, N_MEM, XATTN_HEADS, XATTN_HEAD_DIM)
    v = (memn @ wv).reshape(B, N_MEM, XATTN_HEADS, XATTN_HEAD_DIM)
    s = jnp.einsum('bshd,bmhd->bhsm', q, k).astype(jnp.float32) * (XATTN_HEAD_DIM ** -0.5)
    pr = jax.nn.softmax(s, axis=-1).astype(v.dtype)
    o = jnp.einsum('bhsm,bmhd->bshd', pr, v).reshape(B, S, D_MODEL)
    return o @ wo


def conv_ffn(xn, w_up, conv_w, conv_b, w_down):
    S = xn.shape[1]
    h = xn @ w_up
    hp = jnp.pad(h, ((0, 0), (CONV_WIDTH - 1, 0), (0, 0)))
    hc = conv_b + sum(conv_w[k] * hp[:, k:k + S] for k in range(CONV_WIDTH))
    gate, val = jnp.split(hc, 2, axis=-1)
    return (jax.nn.silu(gate) * val) @ w_down


def setup_inputs(seed: int = 0) -> dict:
    key = jax.random.key(seed)
    ks = jax.random.split(key, 24)
    f32 = jnp.float32
    n = lambda k, shape, s: (jax.random.normal(k, shape, f32) * s)
    gain = lambda k, shape: 1.0 + 0.05 * jax.random.normal(k, shape, f32)
    L = DEPTH
    return {
        "x": jax.random.normal(ks[0], (BATCH, SEQ, D_MODEL), f32),
        "mem": jax.random.normal(ks[1], (BATCH, N_MEM, D_MODEL), f32),
        "norm_mix_g": gain(ks[2], (L, D_MODEL)),
        "w_in": n(ks[3], (L, D_MODEL, D_IN_PROJ), D_MODEL ** -0.5),
        "pool_w": n(ks[4], (L, POOL_GROUPS, POOL_GROUP_DIM, POOL_GROUP_DIM), POOL_GROUP_DIM ** -0.5),
        "pool_scale": 1.0 + 0.1 * jax.random.normal(ks[5], (L, POOL_WIDTH), f32),
        "sgu_g": gain(ks[6], (L, SGU_WIDTH)),
        "sgu_w": n(ks[7], (L, SGU_HEADS, CHUNK, CHUNK), CHUNK ** -0.5),
        "sgu_b": 1.0 + 0.05 * jax.random.normal(ks[8], (L, SGU_HEADS, CHUNK), f32),
        "w_out": n(ks[9], (L, D_MIX, D_MODEL), D_MIX ** -0.5),
        "norm_xattn_g": gain(ks[10], (L, D_MODEL)),
        "mem_norm_g": gain(ks[11], (L, D_MODEL)),
        "wq": n(ks[12], (L, D_MODEL, D_MODEL), D_MODEL ** -0.5),
        "wk": n(ks[13], (L, D_MODEL, D_MODEL), D_MODEL ** -0.5),
        "wv": n(ks[14], (L, D_MODEL, D_MODEL), D_MODEL ** -0.5),
        "wo": n(ks[15], (L, D_MODEL, D_MODEL), D_MODEL ** -0.5),
        "norm_ffn_g": gain(ks[16], (L, D_MODEL)),
        "w_up": n(ks[17], (L, D_MODEL, 2 * D_FF), D_MODEL ** -0.5),
        "conv_w": n(ks[18], (L, CONV_WIDTH, 2 * D_FF), CONV_WIDTH ** -0.5),
        "conv_b": n(ks[19], (L, 2 * D_FF), 0.02),
        "w_down": n(ks[20], (L, D_FF, D_MODEL), D_FF ** -0.5),
        "final_norm_g": gain(ks[21], (D_MODEL,)),
    }


def reference(x, mem, norm_mix_g, w_in, pool_w, pool_scale, sgu_g, sgu_w, sgu_b, w_out,
              norm_xattn_g, mem_norm_g, wq, wk, wv, wo,
              norm_ffn_g, w_up, conv_w, conv_b, w_down, final_norm_g):
    h = x
    for l in range(DEPTH):
        xn = rmsnorm(h, norm_mix_g[l])
        proj = xn @ w_in[l]
        p = proj[..., :POOL_WIDTH]
        uv = jax.nn.gelu(proj[..., POOL_WIDTH:], approximate=False)
        u, v = uv[..., :SGU_WIDTH], uv[..., SGU_WIDTH:]
        y_pool = pool_mixer(p, pool_w[l], pool_scale[l])
        y_sgu = sgu_mixer(u, v, sgu_g[l], sgu_w[l], sgu_b[l])
        h = h + jnp.concatenate([y_pool, y_sgu], axis=-1) @ w_out[l]
        xn = rmsnorm(h, norm_xattn_g[l])
        h = h + mem_cross_attention(xn, mem, mem_norm_g[l], wq[l], wk[l], wv[l], wo[l])
        xn = rmsnorm(h, norm_ffn_g[l])
        h = h + conv_ffn(xn, w_up[l], conv_w[l], conv_b[l], w_down[l])
    return rmsnorm(h, final_norm_g)
```

```cpp
#include <hip/hip_runtime.h>
#include <hip/hip_cooperative_groups.h>
#include <cstdio>
#include <cstdint>
namespace cg = cooperative_groups;
__device__ __forceinline__ int hw_lane() { int l; asm volatile("v_mbcnt_lo_u32_b32 %0, -1, 0\n\tv_mbcnt_hi_u32_b32 %0, -1, %0" : "=v"(l)); return l; }
namespace pg8 {
#define PG8_LAS __attribute__((address_space(3)))
typedef unsigned short bf16_t;
typedef short bf16x8 __attribute__((ext_vector_type(8)));
typedef float f32x4 __attribute__((ext_vector_type(4)));
typedef unsigned u32x4 __attribute__((ext_vector_type(4)));
constexpr int BM = 256, BK = 64, HALF = 128, HTB = HALF * BK * 2  , STAGE_BYTES = 8 * HTB, NXCD = 8, WGM = 4;

__host__ __device__ __forceinline__ int lds_byte(int r, int c) { const int st = (r >> 4) * 2 + (c >> 5), rr = r & 15, cc = c & 31, ob = rr * 64 + cc * 2; return st * 1024 + (ob ^ (((ob >> 9) & 1) << 5)); }
__host__ __device__ __forceinline__ void stage_rc(int b, int& R, int& C) { const int st = b / 1024, sb = b % 1024, swz = sb ^ (((sb >> 9) & 1) << 5); R = (st >> 1) * 16 + swz / 64; C = (st & 1) * 32 + (swz % 64) / 2; }
__host__ __device__ __forceinline__ int perm32(int rho) { const int n = rho >> 4, i = rho & 15; return 8 * (i >> 2) + 4 * n + (i & 3); }

struct Unit { int pm, pn; };
struct Gemm { const bf16_t* A; const bf16_t* Bt; int M, N, K; int bsh; size_t bstride; int ash; size_t astride; };

struct StaticOrder {
    int nM, nN, nwg, G, c;
    __host__ __device__ __forceinline__ void init(int M, int N, int G_, int c_) { nM = M / BM; nN = N / BM; nwg = nM * nN; G = G_; c = c_; }
    __host__ __device__ __forceinline__ bool next(int i, Unit& u) const {
        const long L = (long)i * G + c; if (L >= nwg) return false;
        int wgid = (int)L; { const int q = nwg / NXCD, r = nwg % NXCD, xcd = wgid % NXCD, off = wgid / NXCD; wgid = (xcd < r ? xcd * (q + 1) : r * (q + 1) + (xcd - r) * q) + off; }
        const int nig = WGM * nN, gid = wgid / nig, fm = gid * WGM, gsz = (nM - fm) < WGM ? (nM - fm) : WGM;
        u.pm = fm + ((wgid % nig) % gsz); u.pn = (wgid % nig) / gsz; return true;
    }
    __device__ __forceinline__ void a_ready(const Unit&) const {}
    __device__ __forceinline__ void done(const Unit&) const {}
};

__device__ __forceinline__ unsigned cvt_pk_bf16(float lo, float hi) { unsigned r; asm volatile("v_cvt_pk_bf16_f32 %0, %1, %2" : "=v"(r) : "v"(lo), "v"(hi)); return r; }
typedef float f32x2 __attribute__((ext_vector_type(2)));
__device__ __forceinline__ f32x2 gelu_pk(f32x2 v) {
    const f32x2 av = __builtin_elementwise_abs(v), d = av * 0.2316418882f + 1.0f;
    f32x2 t; t.x = __builtin_amdgcn_rcpf(d.x); t.y = __builtin_amdgcn_rcpf(d.y);
    f32x2 q = t * 0.5307027145f + (-0.7265760135f); q = q * t + 0.7107068705f; q = q * t + (-0.142248368f); q = q * t + 0.127414796f; q = q * t;
    const f32x2 s = (v * v) * (-0.72134752044f);
    f32x2 e; e.x = __builtin_amdgcn_exp2f(s.x); e.y = __builtin_amdgcn_exp2f(s.y);
    const f32x2 m = v * (q * e), r = v - m;
    f32x2 o; o.x = v.x < 0.f ? m.x : r.x; o.y = v.y < 0.f ? m.y : r.y; return o;
}
typedef unsigned u32x2v __attribute__((ext_vector_type(2)));
__device__ __forceinline__ float row_rstd(const float* slots, int row) {
    const f32x4* s = (const f32x4*)(slots + (size_t)row * 16);
    const f32x4 a = s[0], b = s[1], c = s[2], d = s[3];
    const f32x4 t = (a + b) + (c + d);
    const float ss = (t[0] + t[1]) + (t[2] + t[3]);
    return __builtin_amdgcn_rsqf(ss * (1.0f / 1024.0f) + 1e-6f);
}
__device__ __forceinline__ void load_rs(const float* slots, int rowbase, int fr, int fq, float scale, float (&rs)[2][4]) {
    float loc[2];
#pragma unroll
    for (int ai = 0; ai < 2; ++ai) loc[ai] = scale * row_rstd(slots, rowbase + ai * HALF + fq * 16 + fr);
#pragma unroll
    for (int ai = 0; ai < 2; ++ai)
#pragma unroll
        for (int m = 0; m < 4; ++m) rs[ai][m] = __shfl(loc[ai], m * 16 + fr);
}
struct EpiBf16S {
    static constexpr bool PERM = true, AFTER_DRAIN = false;
    bf16_t* O; int ldc; size_t sm, sn;     const float* slots; float scale; int gelu_pn0; float* vstat; int vstat_pn0; size_t bgap;
    __device__ __forceinline__ void operator()(const f32x4 (&acc)[2][2][4][2], const Unit& u, int wr, int wc, int fr, int fq) const {
        const int row0 = u.pm * BM + wr * 64 + fr, col0 = u.pn * BM + wc * 32 + 8 * fq;
        const bool do_gelu = u.pn >= gelu_pn0, do_stat = u.pn >= vstat_pn0;
        float rs[2][4];
        if (slots) load_rs(slots, u.pm * BM + wr * 64, fr, fq, scale, rs);
        else {
#pragma unroll
            for (int ai = 0; ai < 2; ++ai)
#pragma unroll
                for (int m = 0; m < 4; ++m) rs[ai][m] = scale; }
#pragma unroll
        for (int ai = 0; ai < 2; ++ai)
#pragma unroll
            for (int m = 0; m < 4; ++m) { bf16_t* rowp = O + (size_t)(u.pm >> 5) * bgap + (size_t)u.pm * sm + (size_t)u.pn * sn + (size_t)(wr * 64 + fr + ai * HALF + m * 16) * ldc + wc * 32 + 8 * fq; const float sc = rs[ai][m]; float s1 = 0.f, s2 = 0.f;
#pragma unroll
                for (int bj = 0; bj < 2; ++bj) { f32x4 v0 = acc[ai][bj][m][0] * sc, v1 = acc[ai][bj][m][1] * sc;
                    if (do_gelu) { f32x2 a = gelu_pk((f32x2){v0[0], v0[1]}), b = gelu_pk((f32x2){v0[2], v0[3]}), c = gelu_pk((f32x2){v1[0], v1[1]}), d = gelu_pk((f32x2){v1[2], v1[3]});
                        v0 = (f32x4){a.x, a.y, b.x, b.y}; v1 = (f32x4){c.x, c.y, d.x, d.y}; }
                    if (do_stat) { s1 += ((v0[0] + v0[1]) + (v0[2] + v0[3])) + ((v1[0] + v1[1]) + (v1[2] + v1[3]));
                        s2 += ((v0[0] * v0[0] + v0[1] * v0[1]) + (v0[2] * v0[2] + v0[3] * v0[3])) + ((v1[0] * v1[0] + v1[1] * v1[1]) + (v1[2] * v1[2] + v1[3] * v1[3])); }
                    u32x4 w; w.x = cvt_pk_bf16(v0[0], v0[1]); w.y = cvt_pk_bf16(v0[2], v0[3]); w.z = cvt_pk_bf16(v1[0], v1[1]); w.w = cvt_pk_bf16(v1[2], v1[3]);
                    *(u32x4*)(rowp + bj * HALF) = w; }
                if (do_stat) { s1 += __shfl_xor(s1, 16); s1 += __shfl_xor(s1, 32); s2 += __shfl_xor(s2, 16); s2 += __shfl_xor(s2, 32);
                    if (fq == 0) *(f32x2*)(vstat + ((size_t)(row0 + ai * HALF + m * 16) * 8 + (u.pn - vstat_pn0) * 4 + wc) * 2) = (f32x2){s1, s2}; }
                asm volatile("" ::: "memory"); }
    }
};
struct EpiSoftmax {
    static constexpr bool PERM = true, AFTER_DRAIN = false;
    bf16_t* P; const float* slots; float scale; PG8_LAS float* xch; size_t bgap;
    __device__ __forceinline__ void operator()(f32x4 (&acc)[2][2][4][2], const Unit& u, int wr, int wc, int fr, int fq) const {
        float loc[2];
#pragma unroll
        for (int ai = 0; ai < 2; ++ai) loc[ai] = scale * row_rstd(slots, u.pm * BM + wr * 64 + ai * HALF + fq * 16 + fr);
#pragma unroll
        for (int ai = 0; ai < 2; ++ai)
#pragma unroll
            for (int m = 0; m < 4; ++m) { float mx = -3.0e38f; const float rsm = __shfl(loc[ai], m * 16 + fr);
#pragma unroll
                for (int bj = 0; bj < 2; ++bj)
#pragma unroll
                    for (int n = 0; n < 2; ++n) { const f32x4 x = acc[ai][bj][m][n] * rsm; acc[ai][bj][m][n] = x; mx = fmaxf(fmaxf(mx, fmaxf(x[0], x[1])), fmaxf(x[2], x[3])); }
                mx = fmaxf(mx, __shfl_xor(mx, 16)); mx = fmaxf(mx, __shfl_xor(mx, 32));
                if (fq == 0) xch[(ai * HALF + wr * 64 + m * 16 + fr) * 4 + wc] = mx; }
        asm volatile("s_waitcnt lgkmcnt(0)" ::: "memory"); __builtin_amdgcn_s_barrier(); asm volatile("" ::: "memory");
#pragma unroll
        for (int ai = 0; ai < 2; ++ai)
#pragma unroll
            for (int m = 0; m < 4; ++m) { const int r = ai * HALF + wr * 64 + m * 16 + fr; const f32x4 m4 = *(const PG8_LAS f32x4*)(xch + r * 4);
                const float mx = fmaxf(fmaxf(m4[0], m4[1]), fmaxf(m4[2], m4[3])); float sm_ = 0.f;
#pragma unroll
                for (int bj = 0; bj < 2; ++bj)
#pragma unroll
                    for (int n = 0; n < 2; ++n) { f32x4 x = acc[ai][bj][m][n];
#pragma unroll
                        for (int j = 0; j < 4; ++j) { x[j] = __builtin_amdgcn_exp2f(x[j] - mx); sm_ += x[j]; }
                        acc[ai][bj][m][n] = x; }
                sm_ += __shfl_xor(sm_, 16); sm_ += __shfl_xor(sm_, 32);
                if (fq == 0) xch[1024 + r * 4 + wc] = sm_; }
        asm volatile("s_waitcnt lgkmcnt(0)" ::: "memory"); __builtin_amdgcn_s_barrier(); asm volatile("" ::: "memory");
#pragma unroll
        for (int ai = 0; ai < 2; ++ai)
#pragma unroll
            for (int m = 0; m < 4; ++m) { const int r = ai * HALF + wr * 64 + m * 16 + fr; const f32x4 s4 = *(const PG8_LAS f32x4*)(xch + 1024 + r * 4);
                const float inv = 1.0f / ((s4[0] + s4[1]) + (s4[2] + s4[3]));
                bf16_t* rowp = P + (size_t)(u.pm >> 5) * bgap + (size_t)(u.pm * BM + r) * 1024 + u.pn * BM + wc * 32 + 8 * fq;
#pragma unroll
                for (int bj = 0; bj < 2; ++bj) { const f32x4 v0 = acc[ai][bj][m][0] * inv, v1 = acc[ai][bj][m][1] * inv;
                    u32x4 w; w.x = cvt_pk_bf16(v0[0], v0[1]); w.y = cvt_pk_bf16(v0[2], v0[3]); w.z = cvt_pk_bf16(v1[0], v1[1]); w.w = cvt_pk_bf16(v1[2], v1[3]);
                    *(u32x4*)(rowp + bj * HALF) = w; }
                asm volatile("" ::: "memory"); }
    }
};
struct EpiResid {
    static constexpr bool PERM = true, AFTER_DRAIN = false;
    bf16_t* hb; float* slots;
    __device__ __forceinline__ void operator()(const f32x4 (&acc)[2][2][4][2], const Unit& u, int wr, int wc, int fr, int fq) const {
        const int row0 = u.pm * BM + wr * 64 + fr, col0 = u.pn * BM + wc * 32 + 8 * fq;
        u32x4 bw[2][4][2];
#pragma unroll
        for (int ai = 0; ai < 2; ++ai)
#pragma unroll
            for (int m = 0; m < 4; ++m)
#pragma unroll
                for (int bj = 0; bj < 2; ++bj) bw[ai][m][bj] = *(const u32x4*)(hb + (size_t)(row0 + ai * HALF + m * 16) * 1024 + col0 + bj * HALF);
#pragma unroll
        for (int ai = 0; ai < 2; ++ai) {
#pragma unroll
            for (int m = 0; m < 4; ++m) { const int row = row0 + ai * HALF + m * 16; const size_t off = (size_t)row * 1024 + col0; float ss = 0.f;
#pragma unroll
                for (int bj = 0; bj < 2; ++bj) {
                    const u32x4 b = bw[ai][m][bj];
                    const f32x4 b0 = (f32x4){__uint_as_float(b.x << 16), __uint_as_float(b.x & 0xffff0000u), __uint_as_float(b.y << 16), __uint_as_float(b.y & 0xffff0000u)};
                    const f32x4 b1 = (f32x4){__uint_as_float(b.z << 16), __uint_as_float(b.z & 0xffff0000u), __uint_as_float(b.w << 16), __uint_as_float(b.w & 0xffff0000u)};
                    const f32x4 v0 = acc[ai][bj][m][0] + b0, v1 = acc[ai][bj][m][1] + b1;
                    ss += (v0[0] * v0[0] + v0[1] * v0[1]) + (v0[2] * v0[2] + v0[3] * v0[3]) + (v1[0] * v1[0] + v1[1] * v1[1]) + (v1[2] * v1[2] + v1[3] * v1[3]);
                    u32x4 w; w.x = cvt_pk_bf16(v0[0], v0[1]); w.y = cvt_pk_bf16(v0[2], v0[3]); w.z = cvt_pk_bf16(v1[0], v1[1]); w.w = cvt_pk_bf16(v1[2], v1[3]);
                    *(u32x4*)(hb + off + bj * HALF) = w; }
                ss += __shfl_xor(ss, 16); ss += __shfl_xor(ss, 32);
                if (fq == 0) slots[(size_t)row * 16 + u.pn * 4 + wc] = ss; }
            asm volatile("" ::: "memory");
        }
    }
};
__device__ __forceinline__ float dpp_ror1(float x) { return __int_as_float(__builtin_amdgcn_update_dpp(0, __float_as_int(x), 0x121, 0xf, 0xf, false)); }
__device__ __forceinline__ float dpp_ror2(float x) { return __int_as_float(__builtin_amdgcn_update_dpp(0, __float_as_int(x), 0x122, 0xf, 0xf, false)); }
struct EpiUpConv {
    static constexpr bool PERM = true, AFTER_DRAIN = false;
    bf16_t* act; const float* slots; const float* cw; const float* cb; float* rawh; float* hc0; PG8_LAS float* halo;
    __device__ __forceinline__ void operator()(const f32x4 (&acc)[2][2][4][2], const Unit& u, int wr, int wc, int fr, int fq) const {
        constexpr int FF = 2816, FF2 = 5632;
        const int lcol = wc * 32 + 8 * fq, gcol = u.pn * HALF + lcol;
        float rs[2][4];
        load_rs(slots, u.pm * BM + wr * 64, fr, fq, 1.0f, rs);
        if (fr >= 14) {
#pragma unroll
            for (int ai = 0; ai < 2; ++ai)
#pragma unroll
                for (int bj = 0; bj < 2; ++bj)
#pragma unroll
                    for (int n = 0; n < 2; ++n) { const f32x4 x = acc[ai][bj][3][n] * rs[ai][3];
                        *(PG8_LAS f32x4*)(halo + ((ai * 2 + wr) * 2 + (fr - 14)) * 256 + bj * HALF + lcol + 4 * n) = x;
                        if (ai == 1 && wr == 1) *(f32x4*)(rawh + (size_t)(u.pm * 2 + (fr - 14)) * FF2 + bj * FF + gcol + 4 * n) = x; }
        }
        f32x4 w0[2], w1[2], w2[2], bb[2];
#pragma unroll
        for (int bj = 0; bj < 2; ++bj) { const int col = bj * FF + gcol;
            w0[bj] = *(const f32x4*)(cw + col); w1[bj] = *(const f32x4*)(cw + FF2 + col); w2[bj] = *(const f32x4*)(cw + 2 * FF2 + col); bb[bj] = *(const f32x4*)(cb + col); }
        asm volatile("s_waitcnt lgkmcnt(0)" ::: "memory"); __builtin_amdgcn_s_barrier(); asm volatile("" ::: "memory");
        unsigned pk_lo[2][4][2];
#pragma unroll
        for (int n = 0; n < 2; ++n) {
            if (n == 1) {
#pragma unroll
                for (int bj = 0; bj < 2; ++bj) { const int col = bj * FF + gcol + 4;
                    w0[bj] = *(const f32x4*)(cw + col); w1[bj] = *(const f32x4*)(cw + FF2 + col); w2[bj] = *(const f32x4*)(cw + 2 * FF2 + col); bb[bj] = *(const f32x4*)(cb + col); } }
#pragma unroll
            for (int ai = 0; ai < 2; ++ai) {
                f32x4 pg[2]; const int pb = ai * 2 + wr - 1;
#pragma unroll
                for (int bj = 0; bj < 2; ++bj) { pg[bj] = (f32x4){0.f, 0.f, 0.f, 0.f};
                    if (pb >= 0 && fr >= 14) pg[bj] = *(const PG8_LAS f32x4*)(halo + (pb * 2 + (fr - 14)) * 256 + bj * HALF + lcol + 4 * n); }
#pragma unroll
                for (int m = 0; m < 4; ++m) {
                    f32x4 cur[2], h[2];
#pragma unroll
                    for (int bj = 0; bj < 2; ++bj) { cur[bj] = acc[ai][bj][m][n] * rs[ai][m]; f32x4 x1, x2;
#pragma unroll
                        for (int e = 0; e < 4; ++e) { const float c1 = dpp_ror1(cur[bj][e]), p1 = dpp_ror1(pg[bj][e]), c2 = dpp_ror2(cur[bj][e]), p2 = dpp_ror2(pg[bj][e]);
                            x1[e] = fr >= 1 ? c1 : p1; x2[e] = fr >= 2 ? c2 : p2; }
                        h[bj] = bb[bj] + w0[bj] * x2 + w1[bj] * x1 + w2[bj] * cur[bj]; }
                    if (ai == 0 && wr == 0 && m == 0 && fr < 2) {
                        *(f32x4*)(hc0 + (size_t)(u.pm * 2 + fr) * FF2 + gcol + 4 * n) = h[0]; *(f32x4*)(hc0 + (size_t)(u.pm * 2 + fr) * FF2 + FF + gcol + 4 * n) = h[1]; }
                    f32x4 a;
#pragma unroll
                    for (int e = 0; e < 4; ++e) { const float g = h[0][e]; a[e] = g * __builtin_amdgcn_rcpf(1.0f + __builtin_amdgcn_exp2f(-1.4426950408889634f * g)) * h[1][e]; }
                    const unsigned p0 = cvt_pk_bf16(a[0], a[1]), p1 = cvt_pk_bf16(a[2], a[3]);
                    if (n == 0) { pk_lo[ai][m][0] = p0; pk_lo[ai][m][1] = p1; }
                    else { u32x4 w; w.x = pk_lo[ai][m][0]; w.y = pk_lo[ai][m][1]; w.z = p0; w.w = p1;
                        *(u32x4*)(act + (size_t)(u.pm * BM + ai * HALF + wr * 64 + m * 16 + fr) * FF + gcol) = w; }
                    pg[0] = cur[0]; pg[1] = cur[1];
                }
            }
        }
    }
};

template <class Epi, class Sched, bool ALIGN_EPI = false, bool SP2 = false>
__device__ __forceinline__ void gemm_phase(PG8_LAS unsigned char* lds, const Gemm g, const Sched& S, const Epi& E, int wave_in) {
    int tid_l = (wave_in << 6) | hw_lane(); asm volatile("" : "+v"(tid_l));
    const int tid = tid_l, wid = __builtin_amdgcn_readfirstlane(tid >> 6), lane = tid & 63, wr = wid >> 2, wc = wid & 3, fr = lane & 15, fq = lane >> 4;
    const int K = g.K, nt = K / BK;
    unsigned voffA[2], voffB[2];
#pragma unroll
    for (int i = 0; i < 2; ++i) { int R, C; stage_rc(tid * 16 + i * 8192, R, C); const int Rb = Epi::PERM ? ((R & ~31) + perm32(R & 31)) : R;
        voffA[i] = (unsigned)(R * K + C) * 2u; voffB[i] = (unsigned)(Rb * K + C) * 2u; }
    const size_t kstep = (size_t)(BK * 2);
    const size_t hstep = (size_t)HALF * K * 2;
    const size_t tstep = 2 * hstep;
    const unsigned ldsw = (unsigned)wid * 1024u;
    const int aoff = lds_byte(wr * 64 + fr, fq * 8), boff = lds_byte(wc * 32 + fr, fq * 8);
#define PG8_SA(b, h) (((b) * 2 + (h)) * HTB)
#define PG8_SB(b, h) ((4 + (b) * 2 + (h)) * HTB)
#define PG8_STAGE(bufoff, gbase, voff) do { _Pragma("unroll") for (int _i = 0; _i < 2; ++_i) \
        __builtin_amdgcn_global_load_lds((const unsigned*)((const char*)(gbase) + (voff)[_i]), (PG8_LAS unsigned*)(lds + (bufoff) + ldsw + _i * 8192), 16, 0, 0); } while (0)
#define PG8_LDA(dst, b, h) do { _Pragma("unroll") for (int m = 0; m < 4; ++m) _Pragma("unroll") for (int k = 0; k < 2; ++k) dst[m][k] = *(const PG8_LAS bf16x8*)(lds + PG8_SA(b, h) + aoff + m * 2048 + k * 1024); } while (0)
#define PG8_LDB(dst, b, h) do { _Pragma("unroll") for (int n = 0; n < 2; ++n) _Pragma("unroll") for (int k = 0; k < 2; ++k) dst[n][k] = *(const PG8_LAS bf16x8*)(lds + PG8_SB(b, h) + boff + n * 2048 + k * 1024); } while (0)
#define PG8_MMA(ai, bj, At, Bt) do { __builtin_amdgcn_s_setprio(1); _Pragma("unroll") for (int m = 0; m < 4; ++m) _Pragma("unroll") for (int n = 0; n < 2; ++n) _Pragma("unroll") for (int k = 0; k < 2; ++k) \
        acc[ai][bj][m][n] = __builtin_amdgcn_mfma_f32_16x16x32_bf16(Bt[n][k], At[m][k], acc[ai][bj][m][n], 0, 0, 0); __builtin_amdgcn_s_setprio(0); } while (0)
#define PG8_WAIT_V(n) asm volatile("s_waitcnt vmcnt(" #n ")" ::: "memory")
#define PG8_WAIT_L(n) asm volatile("s_waitcnt lgkmcnt(" #n ")" ::: "memory")
#define PG8_BAR __builtin_amdgcn_s_barrier()
#define PG8_SCHED __builtin_amdgcn_sched_barrier(0)
    Unit cur, nxt; int ui = 0;
    if (!S.next(0, cur)) return;
    f32x4 acc[2][2][4][2];
#pragma unroll
    for (int a = 0; a < 2; ++a)
#pragma unroll
        for (int b = 0; b < 2; ++b)
#pragma unroll
            for (int m = 0; m < 4; ++m)
#pragma unroll
                for (int n = 0; n < 2; ++n) acc[a][b][m][n] = (f32x4){0.f, 0.f, 0.f, 0.f};
    bf16x8 At[4][2], B0[2][2], B1[2][2];
    const char* cA = (const char*)g.A + (size_t)(cur.pm >> g.ash) * g.astride + (size_t)cur.pm * tstep; const char* cB = (const char*)g.Bt + (size_t)(cur.pm >> g.bsh) * g.bstride + (size_t)cur.pn * tstep;
    S.a_ready(cur);
    if constexpr (SP2) {
        PG8_STAGE(PG8_SB(0, 0), cB, voffB); PG8_STAGE(PG8_SB(0, 1), cB + hstep, voffB); PG8_STAGE(PG8_SA(0, 0), cA, voffA); PG8_STAGE(PG8_SA(0, 1), cA + hstep, voffA);
        if (wr == 1) PG8_BAR;
        PG8_WAIT_V(2); PG8_BAR;
        PG8_STAGE(PG8_SB(1, 0), cB + kstep, voffB); PG8_STAGE(PG8_SA(1, 0), cA + kstep, voffA); PG8_STAGE(PG8_SB(1, 1), cB + hstep + kstep, voffB);
        PG8_WAIT_V(6); PG8_BAR;
    } else {
        PG8_STAGE(PG8_SB(0, 0), cB, voffB); PG8_STAGE(PG8_SA(0, 0), cA, voffA); PG8_STAGE(PG8_SB(0, 1), cB + hstep, voffB); PG8_STAGE(PG8_SA(0, 1), cA + hstep, voffA);
        if (wr == 1) PG8_BAR;
        PG8_WAIT_V(4); PG8_BAR;
        PG8_STAGE(PG8_SB(1, 0), cB + kstep, voffB); PG8_STAGE(PG8_SA(1, 0), cA + kstep, voffA); PG8_STAGE(PG8_SB(1, 1), cB + hstep + kstep, voffB);
        PG8_WAIT_V(6); PG8_BAR;
    }
    for (;;) {
        const bool has_next = S.next(ui + 1, nxt);
        const char* nA = has_next ? (const char*)g.A + (size_t)(nxt.pm >> g.ash) * g.astride + (size_t)nxt.pm * tstep : cA; const char* nB = has_next ? (const char*)g.Bt + (size_t)(nxt.pm >> g.bsh) * g.bstride + (size_t)nxt.pn * tstep : cB;
        for (int t = 0; t < nt; t += 2) {
            const bool last = (t == nt - 2);
            const char* a1 = cA + (size_t)(t + 1) * kstep;
            const char* a2 = last ? nA : cA + (size_t)(t + 2) * kstep; const char* b2 = last ? nB : cB + (size_t)(t + 2) * kstep;
            const char* a3 = a2 + kstep; const char* b3 = b2 + kstep;
            if (last && has_next) S.a_ready(nxt);
            if constexpr (SP2) {
            PG8_LDB(B0, 0, 0); PG8_LDB(B1, 0, 1); PG8_SCHED; PG8_LDA(At, 0, 0); PG8_STAGE(PG8_SA(1, 1), a1 + hstep, voffA);
            PG8_WAIT_V(8); PG8_WAIT_L(0); PG8_BAR; PG8_MMA(0, 0, At, B0); PG8_MMA(0, 1, At, B1); PG8_BAR; PG8_SCHED;
            PG8_LDA(At, 0, 1); PG8_STAGE(PG8_SB(0, 0), b2, voffB); PG8_STAGE(PG8_SB(0, 1), b2 + hstep, voffB); PG8_STAGE(PG8_SA(0, 0), a2, voffA);
            PG8_WAIT_V(8); PG8_WAIT_L(0); PG8_BAR; PG8_MMA(1, 0, At, B0); PG8_MMA(1, 1, At, B1); PG8_BAR; PG8_SCHED;
            PG8_LDB(B0, 1, 0); PG8_LDB(B1, 1, 1); PG8_SCHED; PG8_LDA(At, 1, 0); PG8_STAGE(PG8_SA(0, 1), a2 + hstep, voffA);
            PG8_WAIT_V(8); PG8_WAIT_L(0); PG8_BAR; PG8_MMA(0, 0, At, B0); PG8_MMA(0, 1, At, B1); PG8_BAR; PG8_SCHED;
            PG8_LDA(At, 1, 1); PG8_STAGE(PG8_SB(1, 0), b3, voffB); PG8_STAGE(PG8_SB(1, 1), b3 + hstep, voffB); PG8_STAGE(PG8_SA(1, 0), a3, voffA);
            PG8_WAIT_V(8); PG8_WAIT_L(0); PG8_BAR; PG8_MMA(1, 0, At, B0); PG8_MMA(1, 1, At, B1); PG8_BAR; PG8_SCHED;
            } else {
            PG8_LDB(B0, 0, 0); PG8_SCHED; PG8_LDA(At, 0, 0); PG8_STAGE(PG8_SA(1, 1), a1 + hstep, voffA);
            PG8_WAIT_L(8); PG8_BAR; PG8_WAIT_L(0); PG8_MMA(0, 0, At, B0); PG8_BAR; PG8_SCHED;
            PG8_LDB(B1, 0, 1); PG8_STAGE(PG8_SB(0, 0), b2, voffB);
            PG8_BAR; PG8_WAIT_L(0); PG8_MMA(0, 1, At, B1); PG8_BAR;
            PG8_LDA(At, 0, 1); PG8_STAGE(PG8_SA(0, 0), a2, voffA);
            PG8_BAR; PG8_WAIT_L(0); PG8_MMA(1, 0, At, B0); PG8_BAR; PG8_SCHED;
            PG8_STAGE(PG8_SB(0, 1), b2 + hstep, voffB);
            PG8_WAIT_V(6); PG8_BAR; PG8_MMA(1, 1, At, B1); PG8_BAR;
            PG8_LDB(B0, 1, 0); PG8_SCHED; PG8_LDA(At, 1, 0); PG8_STAGE(PG8_SA(0, 1), a2 + hstep, voffA);
            PG8_WAIT_L(8); PG8_BAR; PG8_WAIT_L(0); PG8_MMA(0, 0, At, B0); PG8_BAR; PG8_SCHED;
            PG8_LDB(B1, 1, 1); PG8_STAGE(PG8_SB(1, 0), b3, voffB);
            PG8_BAR; PG8_WAIT_L(0); PG8_MMA(0, 1, At, B1); PG8_BAR;
            PG8_LDA(At, 1, 1); PG8_STAGE(PG8_SA(1, 0), a3, voffA);
            PG8_BAR; PG8_WAIT_L(0); PG8_MMA(1, 0, At, B0); PG8_BAR; PG8_SCHED;
            PG8_STAGE(PG8_SB(1, 1), b3 + hstep, voffB);
            PG8_WAIT_V(6); PG8_BAR; PG8_MMA(1, 1, At, B1); PG8_BAR;
            }
        }
        if constexpr (ALIGN_EPI) { if (wr == 0) PG8_BAR; }
        if constexpr (!Epi::AFTER_DRAIN) { E(acc, cur, wr, wc, fr, fq); S.done(cur); }
        if (!has_next) break;
#pragma unroll
        for (int a = 0; a < 2; ++a)
#pragma unroll
            for (int b = 0; b < 2; ++b)
#pragma unroll
                for (int m = 0; m < 4; ++m)
#pragma unroll
                    for (int n = 0; n < 2; ++n) acc[a][b][m][n] = (f32x4){0.f, 0.f, 0.f, 0.f};
        cur = nxt; cA = nA; cB = nB; ++ui;
        if constexpr (ALIGN_EPI) { if (wr == 1) PG8_BAR; }
    }
    PG8_WAIT_V(0);
    if constexpr (!ALIGN_EPI) { if (wr == 0) PG8_BAR; }
    PG8_BAR;
    if constexpr (Epi::AFTER_DRAIN) { E.fused(acc, cur, wr, wc, fr, fq, lds, wid, lane); S.done(cur); }
#undef PG8_SA
#undef PG8_SB
#undef PG8_STAGE
#undef PG8_LDA
#undef PG8_LDB
#undef PG8_MMA
#undef PG8_WAIT_V
#undef PG8_WAIT_L
#undef PG8_BAR
#undef PG8_SCHED
}
}
#define LAS __attribute__((address_space(3)))
typedef unsigned short bf16;
typedef unsigned v4u __attribute__((ext_vector_type(4)));
typedef unsigned v2u __attribute__((ext_vector_type(2)));
typedef float f32x4 __attribute__((ext_vector_type(4)));
typedef short bf16x8 __attribute__((ext_vector_type(8)));
typedef short s16x4 __attribute__((ext_vector_type(4)));
#define MFMA16(a, b, c) __builtin_amdgcn_mfma_f32_16x16x32_bf16((a), (b), (c), 0, 0, 0)

constexpr int BATCH = 8, SEQ = 8192, D = 1024, M = BATCH * SEQ, NMEM = 256, MMEM = BATCH * NMEM, DIN = 1536, FF = 2816, FF2 = 5632, NH = 4, HD = 256, DEPTH = 2;
constexpr float EPS = 1e-6f;
constexpr size_t MiB = 1u << 20;
constexpr size_t WS_W = 1 * MiB, W_LAYER = 32 * MiB;
constexpr size_t W_IN = 0, W_OUT = 3 * MiB, W_Q = 5 * MiB, W_K = 7 * MiB, W_V = 9 * MiB, W_O = 11 * MiB, W_UP = 13 * MiB, W_DN = 24 * MiB, W_POOL = 30 * MiB, W_SGU = 30 * MiB + 256 * 1024;
constexpr size_t WS_MEMN = 65 * MiB, WS_KB = 69 * MiB, WS_VT = 77 * MiB, WS_SLOTS = 85 * MiB, WS_RAWH = 89 * MiB, WS_HC0 = 101 * MiB, WS_HB = 113 * MiB, WS_BIG = 241 * MiB;
constexpr size_t BIG_PROJ = 0, BIG_YMIX = 24 * MiB, BIG_Q = 24 * MiB, BIG_O = 24 * MiB, BIG_ACT = 0, GAP_P = 20 * MiB / 2, GAP_Y = 28 * MiB / 2, WS_VSTAT = WS_BIG + 352 * MiB  , WS_GT = WS_VSTAT + 4 * MiB  , WS_VWT = WS_GT + 32 * MiB  , WS_END = WS_VWT + 32 * MiB;
constexpr int LDS_BYTES = 147456, HALO_OFF = 139264, MISC_OFF = 136192;
constexpr int KPITCH = 528, PP = 272, VP = 1040, DT_OFF = 40960;

__device__ __forceinline__ unsigned f2bf(float f) { unsigned u = __builtin_bit_cast(unsigned, f); return (u + 0x7fffu + ((u >> 16) & 1u)) >> 16; }
__device__ __forceinline__ unsigned pk2(float lo, float hi) { return f2bf(lo) | (f2bf(hi) << 16); }
__device__ __forceinline__ float bflo(unsigned w) { return __uint_as_float(w << 16); }
__device__ __forceinline__ float bfhi(unsigned w) { return __uint_as_float(w & 0xffff0000u); }
__device__ __forceinline__ float wave_sum(float v) {
#pragma unroll
    for (int o = 1; o < 64; o <<= 1) v += __shfl_xor(v, o);
    return v;
}
#define LDS_WAIT() asm volatile("s_waitcnt lgkmcnt(0)" ::: "memory")

__device__ __forceinline__ void transpose_item(const float* W, int K, int N, const float* gk, bf16* WT, bool up_perm, LAS float* scr, int item, int lane) {
    const int nblk = N / 32, kb = item / nblk, nb = item % nblk, k0 = 64 * kb, n0 = 32 * nb;
#pragma unroll 16
    for (int i = 0; i < 32; ++i) { const int kk = 2 * i + (lane >> 5); float w = __builtin_nontemporal_load(W + (size_t)(k0 + kk) * N + n0 + (lane & 31)); if (gk) w *= gk[k0 + kk]; scr[kk * 33 + (lane & 31)] = w; }
    LDS_WAIT(); asm volatile("" ::: "memory");
    int nrow0 = n0; if (up_perm) { const int bj = n0 / FF, i = n0 % FF; nrow0 = 256 * (i / 128) + 128 * bj + (i % 128); }
    const int c = lane & 7;
#pragma unroll
    for (int j = 0; j < 4; ++j) { const int n = (lane >> 3) + 8 * j; const LAS float* s = scr + (8 * c) * 33 + n;
        v4u o; o.x = pk2(s[0 * 33], s[1 * 33]); o.y = pk2(s[2 * 33], s[3 * 33]); o.z = pk2(s[4 * 33], s[5 * 33]); o.w = pk2(s[6 * 33], s[7 * 33]);
        *(v4u*)(WT + (size_t)(nrow0 + n) * K + k0 + 8 * c) = o; }
    LDS_WAIT(); asm volatile("" ::: "memory");
}

struct Args { const float* in[22]; float* out; unsigned char* ws; };
enum { I_X = 0, I_MEM, I_NMIXG, I_WIN, I_POOLW, I_POOLS, I_SGUG, I_SGUW, I_SGUB, I_WOUT, I_NXG, I_MEMG, I_WQ, I_WK, I_WV, I_WO, I_NFG, I_WUP, I_CONVW, I_CONVB, I_WDN, I_FING };

__device__ __forceinline__ void prologue(const Args& a, LAS unsigned char* lds, int gw, int NGW, int lane, int wave) {
    LAS float* scr = (LAS float*)(lds + wave * 8448);
    unsigned char* ws = a.ws;
    constexpr int N_IN = 16 * 48, N_SQ = 16 * 32, N_UP = 16 * 176, N_DN = 44 * 32, N_POOL = 32, PER_L = N_IN + 5 * N_SQ + N_UP + N_DN + N_POOL;
    for (int it = gw; it < DEPTH * PER_L; it += NGW) {
        const int l = it / PER_L; int r = it % PER_L; unsigned char* wl = ws + WS_W + (size_t)l * W_LAYER;
        if (r < N_IN) { transpose_item(a.in[I_WIN] + (size_t)l * D * DIN, D, DIN, a.in[I_NMIXG] + l * D, (bf16*)(wl + W_IN), false, scr, r, lane); continue; } r -= N_IN;
        if (r < N_SQ) { if (r >= 8 * 32) transpose_item(a.in[I_WOUT] + (size_t)l * D * D, D, D, nullptr, (bf16*)(wl + W_OUT), false, scr, r, lane); continue; } r -= N_SQ;
        if (r < N_SQ) {
#pragma unroll
            for (int i = 0; i < 2; ++i) { const int k = 2 * r + i; const float gk = a.in[I_NXG][l * D + k];
#pragma unroll
                for (int j = 0; j < 2; ++j) { const int c = 8 * lane + 512 * j; const f32x4* src = (const f32x4*)(a.in[I_WQ] + (size_t)l * D * D + (size_t)k * D + c); const f32x4 x0 = __builtin_nontemporal_load(src), x1 = __builtin_nontemporal_load(src + 1);
                    v4u o; o.x = pk2(x0[0] * gk, x0[1] * gk); o.y = pk2(x0[2] * gk, x0[3] * gk); o.z = pk2(x1[0] * gk, x1[1] * gk); o.w = pk2(x1[2] * gk, x1[3] * gk);
                    *(v4u*)((bf16*)(wl + W_Q) + ((size_t)(c >> 8) * D + k) * 256 + (c & 255)) = o; } }
            continue; } r -= N_SQ;
        if (r < N_SQ) { transpose_item(a.in[I_WK] + (size_t)l * D * D, D, D, a.in[I_MEMG] + l * D, (bf16*)(wl + W_K), false, scr, r, lane); continue; } r -= N_SQ;
        if (r < N_SQ) { transpose_item(a.in[I_WV] + (size_t)l * D * D, D, D, a.in[I_MEMG] + l * D, (bf16*)(wl + W_V), false, scr, r, lane); continue; } r -= N_SQ;
        if (r < N_SQ) { const int h = r >> 7;
            transpose_item(a.in[I_WO] + (size_t)l * D * D + (size_t)h * 256 * D, 256, D, nullptr, (bf16*)(wl + W_O) + (size_t)h * D * 256, false, scr, r & 127, lane); continue; } r -= N_SQ;
        if (r < N_UP) { transpose_item(a.in[I_WUP] + (size_t)l * D * FF2, D, FF2, a.in[I_NFG] + l * D, (bf16*)(wl + W_UP), true, scr, r, lane); continue; } r -= N_UP;
        if (r < N_DN) { transpose_item(a.in[I_WDN] + (size_t)l * FF * D, FF, D, nullptr, (bf16*)(wl + W_DN), false, scr, r, lane); continue; } r -= N_DN;
        { const int g = r / 8; transpose_item(a.in[I_POOLW] + (size_t)(l * 4 + g) * 128 * 128, 128, 128, nullptr, (bf16*)(wl + W_POOL) + g * 128 * 128, false, scr, r % 8, lane); }
    }
    for (int wi = gw; wi < DEPTH * 1024; wi += NGW) { const int l = wi >> 10, rem = wi & 1023, kc = rem >> 4, n = (rem & 15) * 64 + lane, g = kc >> 4, c0 = (kc & 15) * 8;
        const float* wo_ = a.in[I_WOUT] + (size_t)l * D * D + (size_t)(g * 128) * D + n; const float* pw = a.in[I_POOLW] + (size_t)(l * 4 + g) * 128 * 128 + c0 * 128; const float* ps = a.in[I_POOLS] + l * 512 + g * 128;
        float acc8[8];
#pragma unroll
        for (int i = 0; i < 8; ++i) acc8[i] = 0.f;
#pragma unroll 16
        for (int dd = 0; dd < 128; ++dd) { const float w = wo_[(size_t)dd * D] * ps[dd];
#pragma unroll
            for (int i = 0; i < 8; ++i) acc8[i] += pw[i * 128 + dd] * w; }
        v4u o; o.x = pk2(acc8[0], acc8[1]); o.y = pk2(acc8[2], acc8[3]); o.z = pk2(acc8[4], acc8[5]); o.w = pk2(acc8[6], acc8[7]);
        *(v4u*)((bf16*)(ws + WS_W + (size_t)l * W_LAYER + W_OUT) + (size_t)n * D + g * 128 + c0) = o; }
    for (int i = gw * 64 + lane; i < DEPTH * 4 * 128 * 128; i += NGW * 64) { const int l = i >> 16, rem = i & 65535, t = (rem >> 7) & 127, s = rem & 127;
        const float w = a.in[I_SGUW][i]; ((bf16*)(ws + WS_W + (size_t)l * W_LAYER + W_SGU))[rem] = (bf16)(s <= t ? f2bf(w) : 0u); }
    bf16* HB = (bf16*)(ws + WS_HB); float* slots = (float*)(ws + WS_SLOTS); bf16* MEMN = (bf16*)(ws + WS_MEMN);
    {
        f32x4 nv[4];
        { const int m = gw; if (m < M + MMEM) { const f32x4* xr = (const f32x4*)((m >= M ? a.in[I_MEM] + (size_t)(m - M) * D : a.in[I_X] + (size_t)m * D)) + lane;
#pragma unroll
            for (int j = 0; j < 4; ++j) nv[j] = __builtin_nontemporal_load(xr + 64 * j); } }
        for (int m = gw; m < M + MMEM; m += NGW) {
            const bool is_mem = m >= M; const int row = is_mem ? m - M : m;
            f32x4 v[4]; float s = 0.f;
#pragma unroll
            for (int j = 0; j < 4; ++j) v[j] = nv[j];
            { const int mn = m + NGW; if (mn < M + MMEM) { const f32x4* xr = (const f32x4*)((mn >= M ? a.in[I_MEM] + (size_t)(mn - M) * D : a.in[I_X] + (size_t)mn * D)) + lane;
#pragma unroll
                for (int j = 0; j < 4; ++j) nv[j] = __builtin_nontemporal_load(xr + 64 * j); } }
#pragma unroll
            for (int j = 0; j < 4; ++j) s += (v[j].x * v[j].x + v[j].y * v[j].y) + (v[j].z * v[j].z + v[j].w * v[j].w);
            s = wave_sum(s);
            float sc = 1.f;
            if (is_mem) sc = __builtin_amdgcn_rsqf(s * (1.0f / D) + EPS);
            else if (lane < 16) slots[(size_t)row * 16 + lane] = lane == 0 ? s : 0.f;
            v2u* o8 = (v2u*)((is_mem ? MEMN : HB) + (size_t)row * D) + lane;
#pragma unroll
            for (int j = 0; j < 4; ++j) { v2u o; o.x = pk2(v[j].x * sc, v[j].y * sc); o.y = pk2(v[j].z * sc, v[j].w * sc); o8[64 * j] = o; }
        }
    }
}

#ifndef REP_POOL
#define REP_POOL 1
#endif
#ifndef REP_SGU
#define REP_SGU 1
#endif
constexpr int MIXW = 13056, VP2 = 80;
__device__ __forceinline__ void pool_load(const bf16* proj, int it, int lane, v4u (&raw)[12]) {
    const int chunk = it >> 4, g = (it >> 2) & 3, rq = it & 3; proj += (size_t)(chunk >> 6) * GAP_P;
    const size_t R0 = (size_t)chunk * 128 + rq * 32; const int tseq = (int)(R0 & (SEQ - 1)), r = lane & 15, q = lane >> 4;
#pragma unroll
    for (int i = 0; i < 12; ++i) { const int row = q + 4 * i; raw[i] = (v4u){0u, 0u, 0u, 0u};
        if (row >= 16 || tseq != 0) raw[i] = __builtin_nontemporal_load((const v4u*)(proj + (R0 + row - 16) * DIN + g * 128 + r * 8)); }
}
__device__ __forceinline__ void pool_item(LAS unsigned char* wl, const bf16* proj, bf16* ymix, const bf16* WpT, const float* pscale, int chunk, int g, int rq, int lane, v4u (&raw)[12], int nxt_it) {
    ymix += (size_t)(chunk >> 6) * GAP_Y;
    const size_t R0 = (size_t)chunk * 128 + rq * 32; const int tseq = (int)(R0 & (SEQ - 1));
    const int r = lane & 15, q = lane >> 4, win = 2 << g;
#pragma unroll
    for (int i = 0; i < 12; ++i) *(LAS v4u*)(wl + (q + 4 * i) * PP + r * 16) = raw[i];
    LDS_WAIT();
    if (nxt_it >= 0) pool_load(proj, nxt_it, lane, raw);
    v4u dv[8];
    {
        float s8[8];
#pragma unroll
        for (int e = 0; e < 8; ++e) s8[e] = 0.f;
        for (int k = 1; k < win; ++k) { const v4u v = *(const LAS v4u*)(wl + (8 * q + 16 - k) * PP + r * 16);
            s8[0] += bflo(v.x); s8[1] += bfhi(v.x); s8[2] += bflo(v.y); s8[3] += bfhi(v.y); s8[4] += bflo(v.z); s8[5] += bfhi(v.z); s8[6] += bflo(v.w); s8[7] += bfhi(v.w); }
#pragma unroll
        for (int i = 0; i < 8; ++i) { const int t = 8 * q + i;
            const v4u cur = *(const LAS v4u*)(wl + (t + 16) * PP + r * 16);
            s8[0] += bflo(cur.x); s8[1] += bfhi(cur.x); s8[2] += bflo(cur.y); s8[3] += bfhi(cur.y); s8[4] += bflo(cur.z); s8[5] += bfhi(cur.z); s8[6] += bflo(cur.w); s8[7] += bfhi(cur.w);
            const int cnt = min(tseq + t + 1, win); const float inv = 1.0f / (float)cnt;
            dv[i].x = pk2(s8[0] * inv - bflo(cur.x), s8[1] * inv - bfhi(cur.x)); dv[i].y = pk2(s8[2] * inv - bflo(cur.y), s8[3] * inv - bfhi(cur.y));
            dv[i].z = pk2(s8[4] * inv - bflo(cur.z), s8[5] * inv - bfhi(cur.z)); dv[i].w = pk2(s8[6] * inv - bflo(cur.w), s8[7] * inv - bfhi(cur.w));
            const v4u old = *(const LAS v4u*)(wl + (t + 16 - (win - 1)) * PP + r * 16);
            s8[0] -= bflo(old.x); s8[1] -= bfhi(old.x); s8[2] -= bflo(old.y); s8[3] -= bfhi(old.y); s8[4] -= bflo(old.z); s8[5] -= bfhi(old.z); s8[6] -= bflo(old.w); s8[7] -= bfhi(old.w); }
    }
#pragma unroll
    for (int i = 0; i < 8; ++i) *(v4u*)(ymix + (R0 + 8 * q + i) * D + g * 128 + r * 8) = dv[i];
    LDS_WAIT();
}
__device__ __forceinline__ void sgu_item(LAS unsigned char* wl, const bf16* proj, bf16* ymix, const float* vstat, const float* sgu_g, const bf16* Wm, const float* sgu_b, int chunk, int h, int lane) {
    proj += (size_t)(chunk >> 6) * GAP_P; ymix += (size_t)(chunk >> 6) * GAP_Y;
    typedef float f32x2 __attribute__((ext_vector_type(2)));
    const size_t R0 = (size_t)chunk * 128;
    const int r = lane & 15, q = lane >> 4, c16 = lane & 3, rsub = lane >> 2;
    LAS f32x2* st = (LAS f32x2*)(wl + 128 * VP2);
#pragma unroll
    for (int hh = 0; hh < 2; ++hh) { const f32x4* sp = (const f32x4*)(vstat + (R0 + lane + 64 * hh) * 16);
        const f32x4 a = sp[0], b = sp[1], c = sp[2], d = sp[3];
        const float s1 = ((a[0] + a[2]) + (b[0] + b[2])) + ((c[0] + c[2]) + (d[0] + d[2])), s2 = ((a[1] + a[3]) + (b[1] + b[3])) + ((c[1] + c[3]) + (d[1] + d[3]));
        const float mean = s1 * (1.0f / 512.0f), var = fmaxf(s2 * (1.0f / 512.0f) - mean * mean, 0.f);
        st[lane + 64 * hh] = (f32x2){mean, __builtin_amdgcn_rsqf(var + EPS)}; }
    bf16x8 wmf[20];
    { const bf16* wm = Wm + (size_t)(h * 128 + r) * 128 + q * 8; int f = 0;
#pragma unroll
      for (int ks = 0; ks < 4; ++ks)
#pragma unroll
        for (int tb = 2 * ks; tb < 8; ++tb) wmf[f++] = *(const bf16x8*)(wm + (size_t)(16 * tb) * 128 + ks * 32); }
    float bias[8];
#pragma unroll
    for (int tb = 0; tb < 8; ++tb) bias[tb] = sgu_b[h * 128 + 16 * tb + r];
    LDS_WAIT();
#pragma unroll 1
    for (int dq = 0; dq < 4; ++dq) {
        const int colv = h * 128 + dq * 32;
        v4u raw[8];
#pragma unroll
        for (int i = 0; i < 8; ++i) raw[i] = __builtin_nontemporal_load((const v4u*)(proj + (R0 + rsub + 16 * i) * DIN + 1024 + colv + c16 * 8));
        const f32x4 g0 = *(const f32x4*)(sgu_g + colv + c16 * 8), g1 = *(const f32x4*)(sgu_g + colv + c16 * 8 + 4);
#pragma unroll
        for (int i = 0; i < 8; ++i) { const int s = rsub + 16 * i; const f32x2 ms = st[s]; const v4u w = raw[i];
            v2u lo, hi; lo.x = pk2((bflo(w.x) - ms.x) * ms.y * g0[0], (bfhi(w.x) - ms.x) * ms.y * g0[1]); lo.y = pk2((bflo(w.y) - ms.x) * ms.y * g0[2], (bfhi(w.y) - ms.x) * ms.y * g0[3]);
            hi.x = pk2((bflo(w.z) - ms.x) * ms.y * g1[0], (bfhi(w.z) - ms.x) * ms.y * g1[1]); hi.y = pk2((bflo(w.w) - ms.x) * ms.y * g1[2], (bfhi(w.w) - ms.x) * ms.y * g1[3]);
            *(LAS v2u*)(wl + s * VP2 + (4 * c16) * 2) = lo; *(LAS v2u*)(wl + s * VP2 + (16 + 4 * c16) * 2) = hi; }
        v4u uu8[8];
#pragma unroll
        for (int tb = 0; tb < 8; ++tb) uu8[tb] = __builtin_nontemporal_load((const v4u*)(proj + (R0 + 16 * tb + r) * DIN + 512 + colv + 8 * q));
        LDS_WAIT();
        v2u olo[8];
#pragma unroll
        for (int n = 0; n < 2; ++n) {
            f32x4 z[8];
#pragma unroll
            for (int tb = 0; tb < 8; ++tb) z[tb] = (f32x4){0.f, 0.f, 0.f, 0.f};
            int f = 0;
#pragma unroll
            for (int ks = 0; ks < 4; ++ks) {
                LAS unsigned char* ad = wl + (ks * 32 + 8 * q + (r >> 2)) * VP2 + (16 * n) * 2 + 8 * (r & 3);
                const s16x4 lo = __builtin_bit_cast(s16x4, __builtin_amdgcn_ds_read_tr16_b64_v4i16((LAS s16x4*)ad));
                const s16x4 hi = __builtin_bit_cast(s16x4, __builtin_amdgcn_ds_read_tr16_b64_v4i16((LAS s16x4*)(ad + 4 * VP2)));
                const bf16x8 vf = __builtin_shufflevector(lo, hi, 0, 1, 2, 3, 4, 5, 6, 7);
#pragma unroll
                for (int tb = 2 * ks; tb < 8; ++tb) z[tb] = MFMA16(vf, wmf[f++], z[tb]);
            }
#pragma unroll
            for (int tb = 0; tb < 8; ++tb) { const v4u uu = uu8[tb]; const unsigned ux = n == 0 ? uu.x : uu.z, uy = n == 0 ? uu.y : uu.w;
                v2u o; o.x = pk2(bflo(ux) * (z[tb][0] + bias[tb]), bfhi(ux) * (z[tb][1] + bias[tb])); o.y = pk2(bflo(uy) * (z[tb][2] + bias[tb]), bfhi(uy) * (z[tb][3] + bias[tb]));
                if (n == 0) olo[tb] = o;
                else { v4u w; w.x = olo[tb].x; w.y = olo[tb].y; w.z = o.x; w.w = o.y; *(v4u*)(ymix + (R0 + 16 * tb + r) * D + 512 + colv + 8 * q) = w; } }
        }
        LDS_WAIT();
    }
}
__device__ __forceinline__ void mixer_phase(LAS unsigned char* lds, const bf16* proj, bf16* ymix, const float* vstat, const bf16* WpT, const float* pscale, const float* sgu_g, const bf16* Wm, const float* sgu_b, int pool_first, int pool_step, int pool_limit, int sgu_first, int sgu_step, int sgu_limit, int tid_in) {
    int tid = tid_in; asm volatile("" : "+v"(tid));
    const int lane = tid & 63, wave = __builtin_amdgcn_readfirstlane(tid >> 6);
    LAS unsigned char* wl = lds + wave * MIXW;
    { v4u raw[12]; if (pool_first < pool_limit) pool_load(proj, pool_first, lane, raw);
      for (int it = pool_first; it < pool_limit; it += pool_step) pool_item(wl, proj, ymix, WpT, pscale, it >> 4, (it >> 2) & 3, it & 3, lane, raw, it + pool_step < pool_limit ? it + pool_step : -1); }
    for (int j = sgu_first; j < sgu_limit; j += sgu_step) sgu_item(wl, proj, ymix, vstat, sgu_g, Wm, sgu_b, j >> 2, j & 3, lane);
}

#define ATT_WAITV_BAR() asm volatile("s_waitcnt vmcnt(0) lgkmcnt(0)\n\ts_barrier" ::: "memory")
#define ATT_LGKM_BAR()  asm volatile("s_waitcnt lgkmcnt(0)\n\ts_barrier" ::: "memory")
#define ATT_SB() __builtin_amdgcn_sched_barrier(0)
#define ATT_NB 8
#define ATT_LDN(f, reg, bt) do { _Pragma("unroll") for (int i_ = 0; i_ < ATT_NB; ++i_) f[i_] = *(const LAS bf16x8*)((reg) + (ATT_NB * (bt) + i_) * 1024 + lane * 16); } while (0)
#define ATT_MMA_S(f, bt, kb0) do { _Pragma("unroll") for (int i_ = 0; i_ < ATT_NB; ++i_) { const int kk_ = (ATT_NB * (bt) + i_) >> 3, st_ = (ATT_NB * (bt) + i_) & 7; \
        s[(kb0) + kk_] = MFMA16(f[i_], qf[st_], s[(kb0) + kk_]); } } while (0)
#define ATT_MMA_O(f, bt, kp0) do { _Pragma("unroll") for (int i_ = 0; i_ < ATT_NB; ++i_) { const int db_ = (ATT_NB * (bt) + i_) >> 2, kk_ = (ATT_NB * (bt) + i_) & 3; \
        o[db_] = MFMA16(f[i_], pf[(kp0) + kk_], o[db_]); } } while (0)
#define ATT_SWEEP(reg, MMA, arg) do { bf16x8 fa_[ATT_NB], fb_[ATT_NB]; ATT_LDN(fa_, reg, 0); \
    _Pragma("unroll") for (int bt_ = 0; bt_ < 64 / ATT_NB; bt_ += 2) { ATT_LDN(fb_, reg, bt_ + 1); ATT_SB(); MMA(fa_, bt_, arg); ATT_SB(); \
        if (bt_ + 2 < 64 / ATT_NB) ATT_LDN(fa_, reg, bt_ + 2); ATT_SB(); MMA(fb_, bt_ + 1, arg); ATT_SB(); } } while (0)
__device__ __forceinline__ void attn_dma_k(LAS unsigned char* reg, const bf16* Kbh, int half, int wave, int lane_in) {
    int lane = lane_in; asm volatile("" : "+v"(lane));
    const int r = lane & 15, qd = lane >> 4, kb = 8 * half + wave;
    const int key = 32 * (kb >> 1) + 8 * (r >> 2) + 4 * (kb & 1) + (r & 3);
    const bf16* g = Kbh + (size_t)key * D + qd * 8;
#pragma unroll
    for (int st = 0; st < 8; ++st) __builtin_amdgcn_global_load_lds((const unsigned*)(g + st * 32), (LAS unsigned*)(reg + (wave * 8 + st) * 1024), 16, 0, 0);
}
__device__ __forceinline__ void attn_dma_v(LAS unsigned char* reg, const bf16* Vbh, int half, int wave, int lane_in) {
    int lane = lane_in; asm volatile("" : "+v"(lane));
    const int r = lane & 15, qd = lane >> 4;
#pragma unroll
    for (int i = 0; i < 8; ++i) { const int db = 2 * wave + (i >> 2), kp = 4 * half + (i & 3);
        __builtin_amdgcn_global_load_lds((const unsigned*)(Vbh + (size_t)(16 * db + r) * MMEM + 32 * kp + 8 * qd), (LAS unsigned*)(reg + (wave * 8 + i) * 1024), 16, 0, 0); }
}
__device__ __forceinline__ void attn_phase(LAS unsigned char* lds, const bf16* Q, const bf16* Kb, const bf16* Vt, bf16* O, int bx, int G, int tid_in) {
    int tid = tid_in; asm volatile("" : "+v"(tid));
    const int lane = tid & 63, wave = __builtin_amdgcn_readfirstlane(tid >> 6);
    LAS unsigned char* R0 = lds; LAS unsigned char* R1 = lds + 65536;
    constexpr int NU = BATCH * NH * (SEQ / 128);
    const int nper = NU / G;
    if (G * nper != NU || (G & 7) || ((G >> 3) * nper) % 4) { return; }
    const int xcd = bx & 7, jw = bx >> 3, tiles_per_pair = (G >> 3) * nper / 4;
#define ATT_DECODE(i_, b_, h_, qt_) do { const int per_pair_ = nper / 4, pi_ = (i_) / per_pair_, t_ = (i_) % per_pair_; const int bh_ = xcd + 8 * pi_; b_ = bh_ >> 2; h_ = bh_ & 3; qt_ = jw * per_pair_ + t_; } while (0)
    (void)tiles_per_pair;
    bf16x8 qf[8]; v2u ost[16]; bf16* ostp = nullptr;
#define ATT_QLOAD(b_, h_, qt_) do { int l2_ = lane; asm volatile("" : "+v"(l2_)); const bf16* qp_ = Q + ((size_t)(b_) * SEQ + (qt_) * 128 + wave * 16 + (l2_ & 15)) * D + (h_) * HD + (l2_ >> 4) * 8; \
        _Pragma("unroll") for (int st_ = 0; st_ < 8; ++st_) qf[st_] = *(const bf16x8*)(qp_ + st_ * 32); } while (0)
    { int b, h, qt; ATT_DECODE(0, b, h, qt); ATT_QLOAD(b, h, qt); const bf16* Kbh = Kb + (size_t)(b * NMEM) * D + h * HD; attn_dma_k(R0, Kbh, 0, wave, lane); attn_dma_k(R1, Kbh, 1, wave, lane); }
    for (int ui = 0; ui < nper; ++ui) {
        int b, h, qt, bn, hn, qtn; ATT_DECODE(ui, b, h, qt); const int uin = ui + 1 < nper ? ui + 1 : ui; ATT_DECODE(uin, bn, hn, qtn);
        const bf16* Vbh = Vt + (size_t)(h * HD) * MMEM + b * NMEM; const bf16* Kbhn = Kb + (size_t)(bn * NMEM) * D + hn * HD;
        asm volatile("s_waitcnt vmcnt(8) lgkmcnt(0)\n\ts_barrier" ::: "memory");
        f32x4 s[16];
#pragma unroll
        for (int kb = 0; kb < 16; ++kb) s[kb] = (f32x4){0.f, 0.f, 0.f, 0.f};
        ATT_SWEEP(R0, ATT_MMA_S, 0);
        ATT_WAITV_BAR();
        if (ostp) {
#pragma unroll
            for (int db = 0; db < 16; ++db) *(v2u*)(ostp + db * 16) = ost[db]; }
        attn_dma_v(R0, Vbh, 0, wave, lane);
        ATT_SWEEP(R1, ATT_MMA_S, 8);
        ATT_WAITV_BAR();
        attn_dma_v(R1, Vbh, 1, wave, lane);
        ATT_QLOAD(bn, hn, qtn);
        float linv; bf16x8 pf[8];
        {
            float mx = -3.0e38f;
#pragma unroll
            for (int kb = 0; kb < 16; ++kb) mx = fmaxf(fmaxf(mx, fmaxf(s[kb][0], s[kb][1])), fmaxf(s[kb][2], s[kb][3]));
            mx = fmaxf(mx, __shfl_xor(mx, 16)); mx = fmaxf(mx, __shfl_xor(mx, 32));
            float sum = 0.f;
#pragma unroll
            for (int kb = 0; kb < 16; ++kb)
#pragma unroll
                for (int j = 0; j < 4; ++j) { const float pz = __builtin_amdgcn_exp2f(s[kb][j] - mx); s[kb][j] = pz; sum += pz; }
            sum += __shfl_xor(sum, 16); sum += __shfl_xor(sum, 32); linv = 1.0f / sum;
#pragma unroll
            for (int kp = 0; kp < 8; ++kp) { v4u w; w.x = pk2(s[2 * kp][0], s[2 * kp][1]); w.y = pk2(s[2 * kp][2], s[2 * kp][3]);
                w.z = pk2(s[2 * kp + 1][0], s[2 * kp + 1][1]); w.w = pk2(s[2 * kp + 1][2], s[2 * kp + 1][3]); pf[kp] = __builtin_bit_cast(bf16x8, w); }
        }
        f32x4 o[16];
#pragma unroll
        for (int db = 0; db < 16; ++db) o[db] = (f32x4){0.f, 0.f, 0.f, 0.f};
        ATT_SWEEP(R0, ATT_MMA_O, 0);
        asm volatile("s_waitcnt vmcnt(8) lgkmcnt(0)\n\ts_barrier" ::: "memory");
        attn_dma_k(R0, Kbhn, 0, wave, lane);
        ATT_SWEEP(R1, ATT_MMA_O, 4);
        ATT_LGKM_BAR();
        attn_dma_k(R1, Kbhn, 1, wave, lane);
        { int l3 = lane; asm volatile("" : "+v"(l3)); ostp = O + ((size_t)b * SEQ + qt * 128 + wave * 16 + (l3 & 15)) * D + h * HD + (l3 >> 4) * 4;
#pragma unroll
          for (int db = 0; db < 16; ++db) { ost[db].x = pk2(o[db][0] * linv, o[db][1] * linv); ost[db].y = pk2(o[db][2] * linv, o[db][3] * linv); } }
    }
#pragma unroll
    for (int db = 0; db < 16; ++db) *(v2u*)(ostp + db * 16) = ost[db];
    ATT_WAITV_BAR();
}

#define XB_TMO      128
#define XB_XCNT(j)  (256  + 64 * (j))
#define XB_XSUB(j)  (1280 + 64 * (j))
#define XB_XGEN(j)  (2304 + 64 * (j))
#define XB_TOP      3328
#define XB_TOPGEN   3392
#define XCD_BAR_WORDS 3456
#define XB_SPIN_CAP (1u << 18)

__device__ __forceinline__ unsigned xb_ld(unsigned* p)              { return __hip_atomic_load(p, __ATOMIC_RELAXED, __HIP_MEMORY_SCOPE_AGENT); }
__device__ __forceinline__ unsigned xb_add(unsigned* p, unsigned v) { return __hip_atomic_fetch_add(p, v, __ATOMIC_RELAXED, __HIP_MEMORY_SCOPE_AGENT); }
__device__ __forceinline__ unsigned xb_xcc_id() { return (unsigned)__builtin_amdgcn_s_getreg((3 << 11) | 20) & 0xFu; }
#define XB_SPIN(cond, bar) do { unsigned _sp = 0; while (cond) { __builtin_amdgcn_s_sleep(1); \
    if ((++_sp & 255u) == 0u) { if (xb_ld(&(bar)[XB_TMO])) break; if (_sp > XB_SPIN_CAP) { atomicAdd(&(bar)[XB_TMO], 1u); break; } } } } while (0)

struct XcdBarrier {
    unsigned* bar; unsigned x;
    volatile LAS unsigned* st;
};

__device__ __forceinline__ XcdBarrier xcd_barrier_post(unsigned* bar, volatile LAS unsigned* st) {
    XcdBarrier b; b.bar = bar; b.x = xb_xcc_id(); b.st = st;
    if (threadIdx.x == 0) (void)xb_add(&bar[XB_XCNT(b.x)], 1u);
    return b;
}
__device__ __forceinline__ void xcd_barrier_complete(unsigned* bar, unsigned x, unsigned& nloc, unsigned& nx) {
    const unsigned G = gridDim.x * gridDim.y * gridDim.z;
    unsigned sum, cnt, mine, sp = 0u;
    for (;;) {
        sum = 0u; cnt = 0u; mine = 0u;
#pragma unroll
        for (unsigned j = 0; j < 16; ++j) { const unsigned c = xb_ld(&bar[XB_XCNT(j)]); sum += c; cnt += (c > 0u) ? 1u : 0u; mine = (j == x) ? c : mine; }
        if (sum == G) break;
        __builtin_amdgcn_s_sleep(1);
        if ((++sp & 255u) == 0u) { if (xb_ld(&bar[XB_TMO])) break; if (sp > XB_SPIN_CAP) { atomicAdd(&bar[XB_TMO], 1u); break; } }
    }
    nloc = mine > 0u ? mine : 1u; nx = cnt > 0u ? cnt : 1u;
}

__device__ __forceinline__ void xcd_barrier(const XcdBarrier& b) {
    asm volatile("s_waitcnt vmcnt(0)" ::: "memory");
    __syncthreads();
    if (threadIdx.x == 0) {
        unsigned* bar = b.bar;
        __builtin_amdgcn_s_waitcnt(0);
        unsigned nloc = b.st[0], nx = b.st[1];
        if (nloc == 0u) { xcd_barrier_complete(bar, b.x, nloc, nx); b.st[0] = nloc; b.st[1] = nx; }
        const unsigned old = xb_add(&bar[XB_XSUB(b.x)], 1u);
        const unsigned gen = old / nloc;
        if (old + 1u == (gen + 1u) * nloc) {
            __builtin_amdgcn_fence(__ATOMIC_RELEASE, "agent");
            asm volatile("s_waitcnt vmcnt(0)" ::: "memory");
            const unsigned og = xb_add(&bar[XB_TOP], 1u);
            const unsigned tg = og / nx;
            if (og + 1u == (tg + 1u) * nx) xb_add(&bar[XB_TOPGEN], 1u);
            else XB_SPIN(xb_ld(&bar[XB_TOPGEN]) == tg, bar);
            __builtin_amdgcn_fence(__ATOMIC_ACQUIRE, "agent");
            xb_add(&bar[XB_XGEN(b.x)], 1u);
            asm volatile("s_waitcnt vmcnt(0)" ::: "memory");
        } else {
            XB_SPIN(xb_ld(&bar[XB_XGEN(b.x)]) == gen, bar);
            __builtin_amdgcn_fence(__ATOMIC_ACQUIRE, "agent");
            asm volatile("s_waitcnt vmcnt(0)" ::: "memory");
        }
    }
    __syncthreads();
}

#define GB_CNT(x)   (4096 + 64 * (x))
#define GB_MISMATCH 4608
#define GB_XCCTAB   8192
#define GB_WORDS    8704
__device__ __forceinline__ void grp_barrier(unsigned* ctl, int grp) {
    asm volatile("s_waitcnt vmcnt(0)" ::: "memory");
    __syncthreads();
    if (threadIdx.x == 0) {
        const unsigned old = xb_add(&ctl[GB_CNT(grp)], 1u), target = (old / 32u + 1u) * 32u;
        XB_SPIN(xb_ld(&ctl[GB_CNT(grp)]) < target, ctl);
        __builtin_amdgcn_fence(__ATOMIC_ACQUIRE, "agent");
        asm volatile("s_waitcnt vmcnt(0)" ::: "memory");
    }
    __syncthreads();
}
#ifndef GEMM_ALIGN
#define GEMM_ALIGN true
#endif
#ifndef GEMM_SP2
#define GEMM_SP2 true
#endif
#ifndef FORCE_SLOW
#define FORCE_SLOW 0
#endif
#ifndef GROUP_SEAMS
#define GROUP_SEAMS 1
#endif
#ifndef REP_PRO
#define REP_PRO 1
#endif
#ifndef UP_STAGGER
#define UP_STAGGER 0
#endif
#ifndef REP_Q
#define REP_Q 1
#endif
#ifndef REP_MIX
#define REP_MIX 1
#endif
#ifndef REP_ATTN
#define REP_ATTN 1
#endif
#ifndef REP_UP
#define REP_UP 1
#endif
#ifndef REP_SYNC
#define REP_SYNC 1
#endif
#ifndef REP_INP
#define REP_INP 1
#endif
#define GRID_SYNC() do { for (int rs_ = 0; rs_ < REP_SYNC; ++rs_) xcd_barrier(xbar); } while (0)
#define SEAM_GRP() do { if (((volatile LAS unsigned*)(lds + MISC_OFF))[2]) grp_barrier((unsigned*)ws, (int)blockIdx.x & 7); else xcd_barrier(xbar); } while (0)
#ifndef SKIP_RES
#define SKIP_RES 0
#endif
#ifndef SKIP_BF
#define SKIP_BF 0
#endif
#ifndef SKIP_KV
#define SKIP_KV 0
#endif
#ifndef SKIP_PRO
#define SKIP_PRO 0
#endif
#ifndef SKIP_UP
#define SKIP_UP 0
#endif
__device__ __forceinline__ int fresh_tid_w(int w) { int t = (w << 6) | hw_lane(); asm volatile("" : "+v"(t)); return t; }
__device__ __forceinline__ unsigned char* fresh_ptr(unsigned char* p) { asm volatile("" : "+s"(p)); return p; }
__global__ void __launch_bounds__(512, 2) fwd_megakernel(Args a) {
    extern __shared__ __attribute__((aligned(16))) unsigned char lds_raw[];
    LAS unsigned char* lds = (LAS unsigned char*)lds_raw;
    cg::grid_group grid = cg::this_grid();
    const int wave_s = __builtin_amdgcn_readfirstlane((int)threadIdx.x >> 6);
#define tid  (fresh_tid_w(wave_s))
#define lane (hw_lane())
#define wave (wave_s)
#define gw   ((int)blockIdx.x * 8 + wave)
    const int G = gridDim.x, bx = blockIdx.x, NGW = G * 8;
#define ws   (fresh_ptr(a.ws))
#define HB   ((bf16*)(ws + WS_HB))
#define slots ((float*)(ws + WS_SLOTS))
#define MEMN ((bf16*)(ws + WS_MEMN))
#define PROJ ((bf16*)(ws + WS_BIG + BIG_PROJ))
#define YMIX ((bf16*)(ws + WS_BIG + BIG_YMIX))
#define QB   ((bf16*)(ws + WS_BIG + BIG_Q))
#define OB   ((bf16*)(ws + WS_BIG + BIG_O))
#define ACT  ((bf16*)(ws + WS_BIG + BIG_ACT))
#define RAWH ((float*)(ws + WS_RAWH))
#define HC0  ((float*)(ws + WS_HC0))
#define VSTAT ((float*)(ws + WS_VSTAT))
    float* hres = a.out;

    unsigned* barw = (unsigned*)ws;
    if (bx == 0) for (int i = tid; i < GB_XCCTAB; i += 512) __hip_atomic_store(barw + i, 0u, __ATOMIC_RELAXED, __HIP_MEMORY_SCOPE_AGENT);
    if (tid == 0) __hip_atomic_store(barw + GB_XCCTAB + bx, xb_xcc_id() + 1u, __ATOMIC_RELAXED, __HIP_MEMORY_SCOPE_AGENT);
    volatile LAS unsigned* bst = (volatile LAS unsigned*)(lds + MISC_OFF);
    if (tid == 0) { bst[0] = 0u; bst[1] = 0u; }
    for (int rp_ = 0; rp_ < REP_PRO; ++rp_) prologue(a, lds, gw, NGW, lane, wave);
    grid.sync();
    const XcdBarrier xbar = xcd_barrier_post(barw, bst);
#define grouped (GROUP_SEAMS && gridDim.x == 256)
#define grp ((int)blockIdx.x & 7)
#define gj  ((int)blockIdx.x >> 3)
    { const int t_ = tid; int mism = 0;
      if (t_ < G && t_ < 512) mism = __hip_atomic_load(barw + GB_XCCTAB + t_, __ATOMIC_RELAXED, __HIP_MEMORY_SCOPE_AGENT) != __hip_atomic_load(barw + GB_XCCTAB + (t_ & 7), __ATOMIC_RELAXED, __HIP_MEMORY_SCOPE_AGENT);
      const int any = __syncthreads_or(mism);
      if (t_ == 0) bst[2] = (grouped && !any && !FORCE_SLOW) ? 1u : 0u;
      __syncthreads(); }

#pragma unroll 1
    for (int i = 0; i < 2 * DEPTH; ++i) { const int l = i >> 1; const bool isv = i & 1; unsigned char* wl = ws + WS_W + (size_t)l * W_LAYER;
        pg8::Gemm g{MEMN, (const bf16*)(wl + (isv ? W_V : W_K)), MMEM, D, D, 0, 0};
        int c_ = (bx + G - 64 * i) % G;
        if (grouped) { const int wg_ = ((grp >> 2) << 4) | ((gj & 3) << 2) | (grp & 3); c_ = (gj < 16 && (gj >> 2) == i) ? ((wg_ & 3) << 3) | (wg_ >> 2) : (1 << 20); }
        pg8::StaticOrder S; S.init(g.M, g.N, G, c_);
        pg8::EpiBf16S E{(bf16*)(ws + (isv ? WS_VT : WS_KB) + (size_t)l * 4 * MiB), 256, (size_t)4 * 65536, (size_t)65536, nullptr, 1.0f, 1 << 30, nullptr, 1 << 30};
        if (!SKIP_KV) pg8::gemm_phase<pg8::EpiBf16S, pg8::StaticOrder, GEMM_ALIGN, GEMM_SP2>(lds, g, S, E, wave_s);
    }

#pragma unroll 1
    for (int l = 0; l < DEPTH; ++l) {
        unsigned char* wl = ws + WS_W + (size_t)l * W_LAYER;
        { pg8::Gemm g{HB, (const bf16*)(wl + W_IN), M, DIN, D}; pg8::StaticOrder S; S.init(M, DIN, G, bx);
          pg8::EpiBf16S E{PROJ, DIN, (size_t)256 * DIN, (size_t)256, slots, 1.0f, 2, VSTAT, 4, GAP_P};
          for (int rep = 0; rep < REP_INP; ++rep) pg8::gemm_phase<pg8::EpiBf16S, pg8::StaticOrder, GEMM_ALIGN, GEMM_SP2>(lds, g, S, E, wave_s); }
        SEAM_GRP();
        if (l == 0) {
#pragma unroll 1
            for (int cq = 0; cq < (grouped ? 2 : DEPTH * 64); ++cq) {
                const int ci = grouped ? (((cq * 8 + (gj >> 2)) >> 2) << 5) | (grp << 2) | ((cq * 8 + (gj >> 2)) & 3) : cq;
                const int l2 = ci >> 6, isvw = (ci >> 5) & 1, bh = ci & 31, b = bh >> 2, h = bh & 3; unsigned char* wl2 = ws + WS_W + (size_t)l2 * W_LAYER;
                const bf16* Khd = (const bf16*)(ws + (isvw ? WS_VT : WS_KB) + (size_t)l2 * 4 * MiB) + (size_t)(b * 4 + h) * 65536;
                const bf16* Whd = (const bf16*)(wl2 + (isvw ? W_O : W_Q)) + (size_t)h * D * 256;
                pg8::Gemm g{isvw ? Whd : Khd, isvw ? Khd : Whd, isvw ? D : 256, isvw ? 256 : D, 256, 0, 0};
                pg8::StaticOrder S; S.init(g.M, g.N, G, grouped ? (gj & 3) : (bx + G - (4 * ci) % G) % G);
                bf16* Od = (bf16*)(ws + (isvw ? WS_VWT : WS_GT) + (size_t)l2 * 16 * MiB + (size_t)b * 2 * MiB) + (isvw ? (size_t)h * 256 : (size_t)h * 256 * D);
                pg8::EpiBf16S E{Od, D, (size_t)256 * D, (size_t)256, nullptr, 1.0f, 1 << 30, nullptr, 1 << 30};
                pg8::gemm_phase<pg8::EpiBf16S, pg8::StaticOrder, GEMM_ALIGN, GEMM_SP2>(lds, g, S, E, wave_s);
            }
        }
        { const int w_ = wave;
          const int pf = grouped ? grp * 1024 + gj * 32 + w_ * 4 : gw, pstep = grouped ? 1 : NGW, plim = grouped ? pf + 4 : (M / 128) * 16;
          const int sf = grouped ? grp * 256 + gj * 8 + w_ : gw, sstep = grouped ? 1 : NGW, slim = grouped ? sf + 1 : (M / 128) * 4;
          for (int rep = 0; rep < REP_MIX; ++rep) mixer_phase(lds, PROJ, YMIX, VSTAT, (const bf16*)(wl + W_POOL), a.in[I_POOLS] + l * 512, a.in[I_SGUG] + l * 512, (const bf16*)(wl + W_SGU), a.in[I_SGUB] + l * 512, pf, pstep, plim, sf, sstep, slim, tid); }
        __syncthreads();
        SEAM_GRP();
        { pg8::Gemm g{YMIX, (const bf16*)(wl + W_OUT), M, D, D, 0, 0, 5, GAP_Y * 2}; pg8::StaticOrder S; S.init(M, D, G, bx);
          pg8::EpiResid E{HB, slots};
          if (!SKIP_RES) pg8::gemm_phase<pg8::EpiResid, pg8::StaticOrder, GEMM_ALIGN, GEMM_SP2>(lds, g, S, E, wave_s); }
        SEAM_GRP();
        { pg8::Gemm g{HB, (const bf16*)(ws + WS_GT + (size_t)l * 16 * MiB), M, D, D, 5, (size_t)2 * MiB}; pg8::StaticOrder S; S.init(M, D, G, bx);
          pg8::EpiSoftmax E{QB, slots, 0.0625f * 1.4426950408889634f, (LAS float*)(lds + HALO_OFF), GAP_Y};
          for (int rep = 0; rep < REP_Q; ++rep) pg8::gemm_phase<pg8::EpiSoftmax, pg8::StaticOrder, true, GEMM_SP2>(lds, g, S, E, wave_s); }
        SEAM_GRP();
        { pg8::Gemm g{QB, (const bf16*)(ws + WS_VWT + (size_t)l * 16 * MiB), M, D, D, 5, (size_t)2 * MiB, 5, GAP_Y * 2}; pg8::StaticOrder S; S.init(M, D, G, bx);
          pg8::EpiResid E{HB, slots};
          if (!SKIP_RES) pg8::gemm_phase<pg8::EpiResid, pg8::StaticOrder, GEMM_ALIGN, GEMM_SP2>(lds, g, S, E, wave_s); }
        SEAM_GRP();
        { pg8::Gemm g{HB, (const bf16*)(wl + W_UP), M, FF2, D}; pg8::StaticOrder S; S.init(M, FF2, G, bx);
          pg8::EpiUpConv E{ACT, slots, a.in[I_CONVW] + (size_t)l * 3 * FF2, a.in[I_CONVB] + (size_t)l * FF2, RAWH, HC0, (LAS float*)(lds + HALO_OFF)};
          if (UP_STAGGER > 0 && ((bx >> 3) & 1)) { for (int i_ = 0; i_ < UP_STAGGER; ++i_) __builtin_amdgcn_s_sleep(127); }
          for (int rep = 0; rep < REP_UP; ++rep) pg8::gemm_phase<pg8::EpiUpConv, pg8::StaticOrder, true, GEMM_SP2>(lds, g, S, E, wave_s); }
        SEAM_GRP();
        { const float* cw = a.in[I_CONVW] + (size_t)l * 3 * FF2; pg8::StaticOrder S; S.init(M, D, G, bx); pg8::Unit uu; const int t_ = tid;
          for (int i = 0; S.next(i, uu); ++i) { const int pm = uu.pm; if ((pm & 31) == 0) continue;
            for (int it = t_; it < 2 * (FF / 4); it += 512) { const int c4 = it % (FF / 4), rr = it / (FF / 4);
              const int col = c4 * 4;
              f32x4 hg = *(const f32x4*)(HC0 + (size_t)(pm * 2 + rr) * FF2 + col), hv = *(const f32x4*)(HC0 + (size_t)(pm * 2 + rr) * FF2 + FF + col);
              const f32x4 x1g = *(const f32x4*)(RAWH + (size_t)((pm - 1) * 2 + 1) * FF2 + col), x1v = *(const f32x4*)(RAWH + (size_t)((pm - 1) * 2 + 1) * FF2 + FF + col);
              const f32x4 x2g = *(const f32x4*)(RAWH + (size_t)((pm - 1) * 2) * FF2 + col), x2v = *(const f32x4*)(RAWH + (size_t)((pm - 1) * 2) * FF2 + FF + col);
              const f32x4 w0g = *(const f32x4*)(cw + col), w0v = *(const f32x4*)(cw + FF + col), w1g = *(const f32x4*)(cw + FF2 + col), w1v = *(const f32x4*)(cw + FF2 + FF + col);
              if (rr == 0) { hg += w0g * x2g + w1g * x1g; hv += w0v * x2v + w1v * x1v; } else { hg += w0g * x1g; hv += w0v * x1v; }
              f32x4 r4;
#pragma unroll
              for (int e = 0; e < 4; ++e) r4[e] = hg[e] * __builtin_amdgcn_rcpf(1.0f + __builtin_amdgcn_exp2f(-1.4426950408889634f * hg[e])) * hv[e];
              v2u w; w.x = pk2(r4[0], r4[1]); w.y = pk2(r4[2], r4[3]);
              *(v2u*)(ACT + (size_t)(pm * 256 + rr) * FF + col) = w; } }
          asm volatile("s_waitcnt vmcnt(0)" ::: "memory"); __syncthreads(); }
        { pg8::Gemm g{ACT, (const bf16*)(wl + W_DN), M, D, FF}; pg8::StaticOrder S; S.init(M, D, G, bx);
          pg8::EpiResid E{HB, slots};
          if (!SKIP_RES) pg8::gemm_phase<pg8::EpiResid, pg8::StaticOrder, GEMM_ALIGN, GEMM_SP2>(lds, g, S, E, wave_s); }
        SEAM_GRP();
    }
    { const float* fg = a.in[I_FING]; const int ln = lane, gw0 = grouped ? grp * SEQ + gj * 256 + wave * 32 : gw, fstep = grouped ? 1 : NGW, flim = grouped ? gw0 + 32 : M;
      v2u nw[4]; float nrs = 0.f;
      if (gw0 < flim) { const v2u* xr = (const v2u*)(HB + (size_t)gw0 * D) + ln; nrs = pg8::row_rstd(slots, gw0);
#pragma unroll
        for (int j = 0; j < 4; ++j) nw[j] = __builtin_nontemporal_load(xr + 64 * j); }
      for (int m = gw0; m < flim; m += fstep) { f32x4* orow = (f32x4*)(hres + (size_t)m * D) + ln;
        v2u w[4]; const float rs = nrs;
#pragma unroll
        for (int j = 0; j < 4; ++j) w[j] = nw[j];
        { const int mn = m + fstep; if (mn < flim) { const v2u* xr = (const v2u*)(HB + (size_t)mn * D) + ln; nrs = pg8::row_rstd(slots, mn);
#pragma unroll
            for (int j = 0; j < 4; ++j) nw[j] = __builtin_nontemporal_load(xr + 64 * j); } }
#pragma unroll
        for (int j = 0; j < 4; ++j) { const f32x4 gg = *((const f32x4*)fg + ln + 64 * j);
            __builtin_nontemporal_store((f32x4){bflo(w[j].x), bfhi(w[j].x), bflo(w[j].y), bfhi(w[j].y)} * rs * gg, orow + 64 * j); } } }
}

#undef tid
#undef lane
#undef wave
#undef gw
#undef grouped
#undef grp
#undef gj
#undef ws
#undef HB
#undef slots
#undef MEMN
#undef PROJ
#undef YMIX
#undef QB
#undef OB
#undef ACT
#undef RAWH
#undef HC0
#undef VSTAT
extern "C" void kernel_launch(void* const* d_in, const int* in_sizes, int n_in, void* d_out, int out_size, void* d_ws, size_t ws_size, hipStream_t stream) {
    static int grid = 0;
    if (grid == 0) {
        if (n_in != 22 || in_sizes[0] != M * D || out_size != M * D || ws_size < WS_END) { fprintf(stderr, "kernel_launch: unexpected shapes (n_in %d, in0 %d, out %d, ws %zu)\n", n_in, n_in > 0 ? in_sizes[0] : -1, out_size, ws_size); grid = -1; return; }
        int dev = 0, cus = 0, per_cu = 0;
        hipGetDevice(&dev); hipDeviceGetAttribute(&cus, hipDeviceAttributeMultiprocessorCount, dev);
        if (hipFuncSetAttribute((const void*)fwd_megakernel, hipFuncAttributeMaxDynamicSharedMemorySize, LDS_BYTES) != hipSuccess) { fprintf(stderr, "kernel_launch: hipFuncSetAttribute failed\n"); grid = -1; return; }
        if (hipOccupancyMaxActiveBlocksPerMultiprocessor(&per_cu, (const void*)fwd_megakernel, 512, LDS_BYTES) != hipSuccess || per_cu < 1) { fprintf(stderr, "kernel_launch: occupancy query says %d\n", per_cu); per_cu = 1; }
        (void)hipGetLastError();
        grid = cus * per_cu;
    }
    if (grid < 0) return;
    Args a{};
    for (int i = 0; i < 22; ++i) a.in[i] = (const float*)d_in[i];
    a.out = (float*)d_out; a.ws = (unsigned char*)d_ws;
    void* args[] = {&a};
    hipError_t e = hipLaunchCooperativeKernel((const void*)fwd_megakernel, dim3(grid), dim3(512), args, LDS_BYTES, stream);
    if (e != hipSuccess) fprintf(stderr, "cooperative launch failed: %s (grid %d)\n", hipGetErrorString(e), grid);
}
```

```cpp
#include <hip/hip_runtime.h>
#include <hip/hip_cooperative_groups.h>
#include <cstdio>
#include <cstdint>
namespace cg = cooperative_groups;
__device__ __forceinline__ int hw_lane() { int l; asm volatile("v_mbcnt_lo_u32_b32 %0, -1, 0\n\tv_mbcnt_hi_u32_b32 %0, -1, %0" : "=v"(l)); return l; }
namespace pg8 {
#define PG8_LAS __attribute__((address_space(3)))
typedef unsigned short bf16_t;
typedef short bf16x8 __attribute__((ext_vector_type(8)));
typedef float f32x4 __attribute__((ext_vector_type(4)));
typedef unsigned u32x4 __attribute__((ext_vector_type(4)));
constexpr int BM = 256, BK = 64, HALF = 128, HTB = HALF * BK * 2  , STAGE_BYTES = 8 * HTB, NXCD = 8, WGM = 4;

__host__ __device__ __forceinline__ int lds_byte(int r, int c) { const int st = (r >> 4) * 2 + (c >> 5), rr = r & 15, cc = c & 31, ob = rr * 64 + cc * 2; return st * 1024 + (ob ^ (((ob >> 9) & 1) << 5)); }
__host__ __device__ __forceinline__ void stage_rc(int b, int& R, int& C) { const int st = b / 1024, sb = b % 1024, swz = sb ^ (((sb >> 9) & 1) << 5); R = (st >> 1) * 16 + swz / 64; C = (st & 1) * 32 + (swz % 64) / 2; }
__host__ __device__ __forceinline__ int perm32(int rho) { const int n = rho >> 4, i = rho & 15; return 8 * (i >> 2) + 4 * n + (i & 3); }

struct Unit { int pm, pn; };
struct Gemm { const bf16_t* A; const bf16_t* Bt; int M, N, K; int bsh; size_t bstride; int ash; size_t astride; };

struct StaticOrder {
    int nM, nN, nwg, G, c;
    __host__ __device__ __forceinline__ void init(int M, int N, int G_, int c_) { nM = M / BM; nN = N / BM; nwg = nM * nN; G = G_; c = c_; }
    __host__ __device__ __forceinline__ bool next(int i, Unit& u) const {
        const long L = (long)i * G + c; if (L >= nwg) return false;
        int wgid = (int)L; { const int q = nwg / NXCD, r = nwg % NXCD, xcd = wgid % NXCD, off = wgid / NXCD; wgid = (xcd < r ? xcd * (q + 1) : r * (q + 1) + (xcd - r) * q) + off; }
        const int nig = WGM * nN, gid = wgid / nig, fm = gid * WGM, gsz = (nM - fm) < WGM ? (nM - fm) : WGM;
        u.pm = fm + ((wgid % nig) % gsz); u.pn = (wgid % nig) / gsz; return true;
    }
    __device__ __forceinline__ void a_ready(const Unit&) const {}
    __device__ __forceinline__ void done(const Unit&) const {}
};

__device__ __forceinline__ unsigned cvt_pk_bf16(float lo, float hi) { unsigned r; asm volatile("v_cvt_pk_bf16_f32 %0, %1, %2" : "=v"(r) : "v"(lo), "v"(hi)); return r; }
typedef float f32x2 __attribute__((ext_vector_type(2)));
__device__ __forceinline__ f32x2 gelu_pk(f32x2 v) {
    const f32x2 av = __builtin_elementwise_abs(v), d = av * 0.2316418882f + 1.0f;
    f32x2 t; t.x = __builtin_amdgcn_rcpf(d.x); t.y = __builtin_amdgcn_rcpf(d.y);
    f32x2 q = t * 0.5307027145f + (-0.7265760135f); q = q * t + 0.7107068705f; q = q * t + (-0.142248368f); q = q * t + 0.127414796f; q = q * t;
    const f32x2 s = (v * v) * (-0.72134752044f);
    f32x2 e; e.x = __builtin_amdgcn_exp2f(s.x); e.y = __builtin_amdgcn_exp2f(s.y);
    const f32x2 m = v * (q * e), r = v - m;
    f32x2 o; o.x = v.x < 0.f ? m.x : r.x; o.y = v.y < 0.f ? m.y : r.y; return o;
}
typedef unsigned u32x2v __attribute__((ext_vector_type(2)));
__device__ __forceinline__ float row_rstd(const float* slots, int row) {
    const f32x4* s = (const f32x4*)(slots + (size_t)row * 16);
    const f32x4 a = s[0], b = s[1], c = s[2], d = s[3];
    const f32x4 t = (a + b) + (c + d);
    const float ss = (t[0] + t[1]) + (t[2] + t[3]);
    return __builtin_amdgcn_rsqf(ss * (1.0f / 1024.0f) + 1e-6f);
}
__device__ __forceinline__ void load_rs(const float* slots, int rowbase, int fr, int fq, float scale, float (&rs)[2][4]) {
    float loc[2];
#pragma unroll
    for (int ai = 0; ai < 2; ++ai) loc[ai] = scale * row_rstd(slots, rowbase + ai * HALF + fq * 16 + fr);
#pragma unroll
    for (int ai = 0; ai < 2; ++ai)
#pragma unroll
        for (int m = 0; m < 4; ++m) rs[ai][m] = __shfl(loc[ai], m * 16 + fr);
}
struct EpiBf16S {
    static constexpr bool PERM = true, AFTER_DRAIN = false;
    bf16_t* O; int ldc; size_t sm, sn;     const float* slots; float scale; int gelu_pn0; float* vstat; int vstat_pn0; size_t bgap;
    __device__ __forceinline__ void operator()(const f32x4 (&acc)[2][2][4][2], const Unit& u, int wr, int wc, int fr, int fq) const {
        const int row0 = u.pm * BM + wr * 64 + fr, col0 = u.pn * BM + wc * 32 + 8 * fq;
        const bool do_gelu = u.pn >= gelu_pn0, do_stat = u.pn >= vstat_pn0;
        float rs[2][4];
        if (slots) load_rs(slots, u.pm * BM + wr * 64, fr, fq, scale, rs);
        else {
#pragma unroll
            for (int ai = 0; ai < 2; ++ai)
#pragma unroll
                for (int m = 0; m < 4; ++m) rs[ai][m] = scale; }
#pragma unroll
        for (int ai = 0; ai < 2; ++ai)
#pragma unroll
            for (int m = 0; m < 4; ++m) { bf16_t* rowp = O + (size_t)(u.pm >> 5) * bgap + (size_t)u.pm * sm + (size_t)u.pn * sn + (size_t)(wr * 64 + fr + ai * HALF + m * 16) * ldc + wc * 32 + 8 * fq; const float sc = rs[ai][m]; float s1 = 0.f, s2 = 0.f;
#pragma unroll
                for (int bj = 0; bj < 2; ++bj) { f32x4 v0 = acc[ai][bj][m][0] * sc, v1 = acc[ai][bj][m][1] * sc;
                    if (do_gelu) { f32x2 a = gelu_pk((f32x2){v0[0], v0[1]}), b = gelu_pk((f32x2){v0[2], v0[3]}), c = gelu_pk((f32x2){v1[0], v1[1]}), d = gelu_pk((f32x2){v1[2], v1[3]});
                        v0 = (f32x4){a.x, a.y, b.x, b.y}; v1 = (f32x4){c.x, c.y, d.x, d.y}; }
                    if (do_stat) { s1 += ((v0[0] + v0[1]) + (v0[2] + v0[3])) + ((v1[0] + v1[1]) + (v1[2] + v1[3]));
                        s2 += ((v0[0] * v0[0] + v0[1] * v0[1]) + (v0[2] * v0[2] + v0[3] * v0[3])) + ((v1[0] * v1[0] + v1[1] * v1[1]) + (v1[2] * v1[2] + v1[3] * v1[3])); }
                    u32x4 w; w.x = cvt_pk_bf16(v0[0], v0[1]); w.y = cvt_pk_bf16(v0[2], v0[3]); w.z = cvt_pk_bf16(v1[0], v1[1]); w.w = cvt_pk_bf16(v1[2], v1[3]);
                    *(u32x4*)(rowp + bj * HALF) = w; }
                if (do_stat) { s1 += __shfl_xor(s1, 16); s1 += __shfl_xor(s1, 32); s2 += __shfl_xor(s2, 16); s2 += __shfl_xor(s2, 32);
                    if (fq == 0) *(f32x2*)(vstat + ((size_t)(row0 + ai * HALF + m * 16) * 8 + (u.pn - vstat_pn0) * 4 + wc) * 2) = (f32x2){s1, s2}; }
                asm volatile("" ::: "memory"); }
    }
};
struct EpiSoftmax {
    static constexpr bool PERM = true, AFTER_DRAIN = false;
    bf16_t* P; const float* slots; float scale; PG8_LAS float* xch; size_t bgap;
    __device__ __forceinline__ void operator()(f32x4 (&acc)[2][2][4][2], const Unit& u, int wr, int wc, int fr, int fq) const {
        float loc[2];
#pragma unroll
        for (int ai = 0; ai < 2; ++ai) loc[ai] = scale * row_rstd(slots, u.pm * BM + wr * 64 + ai * HALF + fq * 16 + fr);
#pragma unroll
        for (int ai = 0; ai < 2; ++ai)
#pragma unroll
            for (int m = 0; m < 4; ++m) { float mx = -3.0e38f; const float rsm = __shfl(loc[ai], m * 16 + fr);
#pragma unroll
                for (int bj = 0; bj < 2; ++bj)
#pragma unroll
                    for (int n = 0; n < 2; ++n) { const f32x4 x = acc[ai][bj][m][n] * rsm; acc[ai][bj][m][n] = x; mx = fmaxf(fmaxf(mx, fmaxf(x[0], x[1])), fmaxf(x[2], x[3])); }
                mx = fmaxf(mx, __shfl_xor(mx, 16)); mx = fmaxf(mx, __shfl_xor(mx, 32));
                if (fq == 0) xch[(ai * HALF + wr * 64 + m * 16 + fr) * 4 + wc] = mx; }
        asm volatile("s_waitcnt lgkmcnt(0)" ::: "memory"); __builtin_amdgcn_s_barrier(); asm volatile("" ::: "memory");
#pragma unroll
        for (int ai = 0; ai < 2; ++ai)
#pragma unroll
            for (int m = 0; m < 4; ++m) { const int r = ai * HALF + wr * 64 + m * 16 + fr; const f32x4 m4 = *(const PG8_LAS f32x4*)(xch + r * 4);
                const float mx = fmaxf(fmaxf(m4[0], m4[1]), fmaxf(m4[2], m4[3])); float sm_ = 0.f;
#pragma unroll
                for (int bj = 0; bj < 2; ++bj)
#pragma unroll
                    for (int n = 0; n < 2; ++n) { f32x4 x = acc[ai][bj][m][n];
#pragma unroll
                        for (int j = 0; j < 4; ++j) { x[j] = __builtin_amdgcn_exp2f(x[j] - mx); sm_ += x[j]; }
                        acc[ai][bj][m][n] = x; }
                sm_ += __shfl_xor(sm_, 16); sm_ += __shfl_xor(sm_, 32);
                if (fq == 0) xch[1024 + r * 4 + wc] = sm_; }
        asm volatile("s_waitcnt lgkmcnt(0)" ::: "memory"); __builtin_amdgcn_s_barrier(); asm volatile("" ::: "memory");
#pragma unroll
        for (int ai = 0; ai < 2; ++ai)
#pragma unroll
            for (int m = 0; m < 4; ++m) { const int r = ai * HALF + wr * 64 + m * 16 + fr; const f32x4 s4 = *(const PG8_LAS f32x4*)(xch + 1024 + r * 4);
                const float inv = 1.0f / ((s4[0] + s4[1]) + (s4[2] + s4[3]));
                bf16_t* rowp = P + (size_t)(u.pm >> 5) * bgap + (size_t)(u.pm * BM + r) * 1024 + u.pn * BM + wc * 32 + 8 * fq;
#pragma unroll
                for (int bj = 0; bj < 2; ++bj) { const f32x4 v0 = acc[ai][bj][m][0] * inv, v1 = acc[ai][bj][m][1] * inv;
                    u32x4 w; w.x = cvt_pk_bf16(v0[0], v0[1]); w.y = cvt_pk_bf16(v0[2], v0[3]); w.z = cvt_pk_bf16(v1[0], v1[1]); w.w = cvt_pk_bf16(v1[2], v1[3]);
                    *(u32x4*)(rowp + bj * HALF) = w; }
                asm volatile("" ::: "memory"); }
    }
};
struct EpiResid {
    static constexpr bool PERM = true, AFTER_DRAIN = false;
    bf16_t* hb; float* slots;
    __device__ __forceinline__ void operator()(const f32x4 (&acc)[2][2][4][2], const Unit& u, int wr, int wc, int fr, int fq) const {
        const int row0 = u.pm * BM + wr * 64 + fr, col0 = u.pn * BM + wc * 32 + 8 * fq;
        u32x4 bw[2][4][2];
#pragma unroll
        for (int ai = 0; ai < 2; ++ai)
#pragma unroll
            for (int m = 0; m < 4; ++m)
#pragma unroll
                for (int bj = 0; bj < 2; ++bj) bw[ai][m][bj] = *(const u32x4*)(hb + (size_t)(row0 + ai * HALF + m * 16) * 1024 + col0 + bj * HALF);
#pragma unroll
        for (int ai = 0; ai < 2; ++ai) {
#pragma unroll
            for (int m = 0; m < 4; ++m) { const int row = row0 + ai * HALF + m * 16; const size_t off = (size_t)row * 1024 + col0; float ss = 0.f;
#pragma unroll
                for (int bj = 0; bj < 2; ++bj) {
                    const u32x4 b = bw[ai][m][bj];
                    const f32x4 b0 = (f32x4){__uint_as_float(b.x << 16), __uint_as_float(b.x & 0xffff0000u), __uint_as_float(b.y << 16), __uint_as_float(b.y & 0xffff0000u)};
                    const f32x4 b1 = (f32x4){__uint_as_float(b.z << 16), __uint_as_float(b.z & 0xffff0000u), __uint_as_float(b.w << 16), __uint_as_float(b.w & 0xffff0000u)};
                    const f32x4 v0 = acc[ai][bj][m][0] + b0, v1 = acc[ai][bj][m][1] + b1;
                    ss += (v0[0] * v0[0] + v0[1] * v0[1]) + (v0[2] * v0[2] + v0[3] * v0[3]) + (v1[0] * v1[0] + v1[1] * v1[1]) + (v1[2] * v1[2] + v1[3] * v1[3]);
                    u32x4 w; w.x = cvt_pk_bf16(v0[0], v0[1]); w.y = cvt_pk_bf16(v0[2], v0[3]); w.z = cvt_pk_bf16(v1[0], v1[1]); w.w = cvt_pk_bf16(v1[2], v1[3]);
                    *(u32x4*)(hb + off + bj * HALF) = w; }
                ss += __shfl_xor(ss, 16); ss += __shfl_xor(ss, 32);
                if (fq == 0) slots[(size_t)row * 16 + u.pn * 4 + wc] = ss; }
            asm volatile("" ::: "memory");
        }
    }
};
__device__ __forceinline__ float dpp_ror1(float x) { return __int_as_float(__builtin_amdgcn_update_dpp(0, __float_as_int(x), 0x121, 0xf, 0xf, false)); }
__device__ __forceinline__ float dpp_ror2(float x) { return __int_as_float(__builtin_amdgcn_update_dpp(0, __float_as_int(x), 0x122, 0xf, 0xf, false)); }
struct EpiUpConv {
    static constexpr bool PERM = true, AFTER_DRAIN = false;
    bf16_t* act; const float* slots; const float* cw; const float* cb; float* rawh; float* hc0; PG8_LAS float* halo;
    __device__ __forceinline__ void operator()(const f32x4 (&acc)[2][2][4][2], const Unit& u, int wr, int wc, int fr, int fq) const {
        constexpr int FF = 2816, FF2 = 5632;
        const int lcol = wc * 32 + 8 * fq, gcol = u.pn * HALF + lcol;
        float rs[2][4];
        load_rs(slots, u.pm * BM + wr * 64, fr, fq, 1.0f, rs);
        if (fr >= 14) {
#pragma unroll
            for (int ai = 0; ai < 2; ++ai)
#pragma unroll
                for (int bj = 0; bj < 2; ++bj)
#pragma unroll
                    for (int n = 0; n < 2; ++n) { const f32x4 x = acc[ai][bj][3][n] * rs[ai][3];
                        *(PG8_LAS f32x4*)(halo + ((ai * 2 + wr) * 2 + (fr - 14)) * 256 + bj * HALF + lcol + 4 * n) = x;
                        if (ai == 1 && wr == 1) *(f32x4*)(rawh + (size_t)(u.pm * 2 + (fr - 14)) * FF2 + bj * FF + gcol + 4 * n) = x; }
        }
        f32x4 w0[2], w1[2], w2[2], bb[2];
#pragma unroll
        for (int bj = 0; bj < 2; ++bj) { const int col = bj * FF + gcol;
            w0[bj] = *(const f32x4*)(cw + col); w1[bj] = *(const f32x4*)(cw + FF2 + col); w2[bj] = *(const f32x4*)(cw + 2 * FF2 + col); bb[bj] = *(const f32x4*)(cb + col); }
        asm volatile("s_waitcnt lgkmcnt(0)" ::: "memory"); __builtin_amdgcn_s_barrier(); asm volatile("" ::: "memory");
        unsigned pk_lo[2][4][2];
#pragma unroll
        for (int n = 0; n < 2; ++n) {
            if (n == 1) {
#pragma unroll
                for (int bj = 0; bj < 2; ++bj) { const int col = bj * FF + gcol + 4;
                    w0[bj] = *(const f32x4*)(cw + col); w1[bj] = *(const f32x4*)(cw + FF2 + col); w2[bj] = *(const f32x4*)(cw + 2 * FF2 + col); bb[bj] = *(const f32x4*)(cb + col); } }
#pragma unroll
            for (int ai = 0; ai < 2; ++ai) {
                f32x4 pg[2]; const int pb = ai * 2 + wr - 1;
#pragma unroll
                for (int bj = 0; bj < 2; ++bj) { pg[bj] = (f32x4){0.f, 0.f, 0.f, 0.f};
                    if (pb >= 0 && fr >= 14) pg[bj] = *(const PG8_LAS f32x4*)(halo + (pb * 2 + (fr - 14)) * 256 + bj * HALF + lcol + 4 * n); }
#pragma unroll
                for (int m = 0; m < 4; ++m) {
                    f32x4 cur[2], h[2];
#pragma unroll
                    for (int bj = 0; bj < 2; ++bj) { cur[bj] = acc[ai][bj][m][n] * rs[ai][m]; f32x4 x1, x2;
#pragma unroll
                        for (int e = 0; e < 4; ++e) { const float c1 = dpp_ror1(cur[bj][e]), p1 = dpp_ror1(pg[bj][e]), c2 = dpp_ror2(cur[bj][e]), p2 = dpp_ror2(pg[bj][e]);
                            x1[e] = fr >= 1 ? c1 : p1; x2[e] = fr >= 2 ? c2 : p2; }
                        h[bj] = bb[bj] + w0[bj] * x2 + w1[bj] * x1 + w2[bj] * cur[bj]; }
                    if (ai == 0 && wr == 0 && m == 0 && fr < 2) {
                        *(f32x4*)(hc0 + (size_t)(u.pm * 2 + fr) * FF2 + gcol + 4 * n) = h[0]; *(f32x4*)(hc0 + (size_t)(u.pm * 2 + fr) * FF2 + FF + gcol + 4 * n) = h[1]; }
                    f32x4 a;
#pragma unroll
                    for (int e = 0; e < 4; ++e) { const float g = h[0][e]; a[e] = g * __builtin_amdgcn_rcpf(1.0f + __builtin_amdgcn_exp2f(-1.4426950408889634f * g)) * h[1][e]; }
                    const unsigned p0 = cvt_pk_bf16(a[0], a[1]), p1 = cvt_pk_bf16(a[2], a[3]);
                    if (n == 0) { pk_lo[ai][m][0] = p0; pk_lo[ai][m][1] = p1; }
                    else { u32x4 w; w.x = pk_lo[ai][m][0]; w.y = pk_lo[ai][m][1]; w.z = p0; w.w = p1;
                        __builtin_nontemporal_store(w, (u32x4*)(act + (size_t)(u.pm * BM + ai * HALF + wr * 64 + m * 16 + fr) * FF + gcol)); }
                    pg[0] = cur[0]; pg[1] = cur[1];
                }
            }
        }
    }
};

template <class Epi, class Sched, bool ALIGN_EPI = false, bool SP2 = false>
__device__ __forceinline__ void gemm_phase(PG8_LAS unsigned char* lds, const Gemm g, const Sched& S, const Epi& E, int wave_in) {
    int tid_l = (wave_in << 6) | hw_lane(); asm volatile("" : "+v"(tid_l));
    const int tid = tid_l, wid = __builtin_amdgcn_readfirstlane(tid >> 6), lane = tid & 63, wr = wid >> 2, wc = wid & 3, fr = lane & 15, fq = lane >> 4;
    const int K = g.K, nt = K / BK;
    unsigned voffA[2], voffB[2];
#pragma unroll
    for (int i = 0; i < 2; ++i) { int R, C; stage_rc(tid * 16 + i * 8192, R, C); const int Rb = Epi::PERM ? ((R & ~31) + perm32(R & 31)) : R;
        voffA[i] = (unsigned)(R * K + C) * 2u; voffB[i] = (unsigned)(Rb * K + C) * 2u; }
    const size_t kstep = (size_t)(BK * 2);
    const size_t hstep = (size_t)HALF * K * 2;
    const size_t tstep = 2 * hstep;
    const unsigned ldsw = (unsigned)wid * 1024u;
    const int aoff = lds_byte(wr * 64 + fr, fq * 8), boff = lds_byte(wc * 32 + fr, fq * 8);
#define PG8_SA(b, h) (((b) * 2 + (h)) * HTB)
#define PG8_SB(b, h) ((4 + (b) * 2 + (h)) * HTB)
#define PG8_STAGE(bufoff, gbase, voff) do { _Pragma("unroll") for (int _i = 0; _i < 2; ++_i) \
        __builtin_amdgcn_global_load_lds((const unsigned*)((const char*)(gbase) + (voff)[_i]), (PG8_LAS unsigned*)(lds + (bufoff) + ldsw + _i * 8192), 16, 0, 0); } while (0)
#define PG8_LDA(dst, b, h) do { _Pragma("unroll") for (int m = 0; m < 4; ++m) _Pragma("unroll") for (int k = 0; k < 2; ++k) dst[m][k] = *(const PG8_LAS bf16x8*)(lds + PG8_SA(b, h) + aoff + m * 2048 + k * 1024); } while (0)
#define PG8_LDB(dst, b, h) do { _Pragma("unroll") for (int n = 0; n < 2; ++n) _Pragma("unroll") for (int k = 0; k < 2; ++k) dst[n][k] = *(const PG8_LAS bf16x8*)(lds + PG8_SB(b, h) + boff + n * 2048 + k * 1024); } while (0)
#define PG8_MMA(ai, bj, At, Bt) do { __builtin_amdgcn_s_setprio(1); _Pragma("unroll") for (int m = 0; m < 4; ++m) _Pragma("unroll") for (int n = 0; n < 2; ++n) _Pragma("unroll") for (int k = 0; k < 2; ++k) \
        acc[ai][bj][m][n] = __builtin_amdgcn_mfma_f32_16x16x32_bf16(Bt[n][k], At[m][k], acc[ai][bj][m][n], 0, 0, 0); __builtin_amdgcn_s_setprio(0); } while (0)
#define PG8_WAIT_V(n) asm volatile("s_waitcnt vmcnt(" #n ")" ::: "memory")
#define PG8_WAIT_L(n) asm volatile("s_waitcnt lgkmcnt(" #n ")" ::: "memory")
#define PG8_BAR __builtin_amdgcn_s_barrier()
#define PG8_SCHED __builtin_amdgcn_sched_barrier(0)
    Unit cur, nxt; int ui = 0;
    if (!S.next(0, cur)) return;
    f32x4 acc[2][2][4][2];
#pragma unroll
    for (int a = 0; a < 2; ++a)
#pragma unroll
        for (int b = 0; b < 2; ++b)
#pragma unroll
            for (int m = 0; m < 4; ++m)
#pragma unroll
                for (int n = 0; n < 2; ++n) acc[a][b][m][n] = (f32x4){0.f, 0.f, 0.f, 0.f};
    bf16x8 At[4][2], B0[2][2], B1[2][2];
    const char* cA = (const char*)g.A + (size_t)(cur.pm >> g.ash) * g.astride + (size_t)cur.pm * tstep; const char* cB = (const char*)g.Bt + (size_t)(cur.pm >> g.bsh) * g.bstride + (size_t)cur.pn * tstep;
    S.a_ready(cur);
    if constexpr (SP2) {
        PG8_STAGE(PG8_SB(0, 0), cB, voffB); PG8_STAGE(PG8_SB(0, 1), cB + hstep, voffB); PG8_STAGE(PG8_SA(0, 0), cA, voffA); PG8_STAGE(PG8_SA(0, 1), cA + hstep, voffA);
        if (wr == 1) PG8_BAR;
        PG8_WAIT_V(2); PG8_BAR;
        PG8_STAGE(PG8_SB(1, 0), cB + kstep, voffB); PG8_STAGE(PG8_SA(1, 0), cA + kstep, voffA); PG8_STAGE(PG8_SB(1, 1), cB + hstep + kstep, voffB);
        PG8_WAIT_V(6); PG8_BAR;
    } else {
        PG8_STAGE(PG8_SB(0, 0), cB, voffB); PG8_STAGE(PG8_SA(0, 0), cA, voffA); PG8_STAGE(PG8_SB(0, 1), cB + hstep, voffB); PG8_STAGE(PG8_SA(0, 1), cA + hstep, voffA);
        if (wr == 1) PG8_BAR;
        PG8_WAIT_V(4); PG8_BAR;
        PG8_STAGE(PG8_SB(1, 0), cB + kstep, voffB); PG8_STAGE(PG8_SA(1, 0), cA + kstep, voffA); PG8_STAGE(PG8_SB(1, 1), cB + hstep + kstep, voffB);
        PG8_WAIT_V(6); PG8_BAR;
    }
    for (;;) {
        const bool has_next = S.next(ui + 1, nxt);
        const char* nA = has_next ? (const char*)g.A + (size_t)(nxt.pm >> g.ash) * g.astride + (size_t)nxt.pm * tstep : cA; const char* nB = has_next ? (const char*)g.Bt + (size_t)(nxt.pm >> g.bsh) * g.bstride + (size_t)nxt.pn * tstep : cB;
        for (int t = 0; t < nt; t += 2) {
            const bool last = (t == nt - 2);
            const char* a1 = cA + (size_t)(t + 1) * kstep;
            const char* a2 = last ? nA : cA + (size_t)(t + 2) * kstep; const char* b2 = last ? nB : cB + (size_t)(t + 2) * kstep;
            const char* a3 = a2 + kstep; const char* b3 = b2 + kstep;
            if (last && has_next) S.a_ready(nxt);
            if constexpr (SP2) {
            PG8_LDB(B0, 0, 0); PG8_LDB(B1, 0, 1); PG8_SCHED; PG8_LDA(At, 0, 0); PG8_STAGE(PG8_SA(1, 1), a1 + hstep, voffA);
            PG8_WAIT_V(8); PG8_WAIT_L(0); PG8_BAR; PG8_MMA(0, 0, At, B0); PG8_MMA(0, 1, At, B1); PG8_BAR; PG8_SCHED;
            PG8_LDA(At, 0, 1); PG8_STAGE(PG8_SB(0, 0), b2, voffB); PG8_STAGE(PG8_SB(0, 1), b2 + hstep, voffB); PG8_STAGE(PG8_SA(0, 0), a2, voffA);
            PG8_WAIT_V(8); PG8_WAIT_L(0); PG8_BAR; PG8_MMA(1, 0, At, B0); PG8_MMA(1, 1, At, B1); PG8_BAR; PG8_SCHED;
            PG8_LDB(B0, 1, 0); PG8_LDB(B1, 1, 1); PG8_SCHED; PG8_LDA(At, 1, 0); PG8_STAGE(PG8_SA(0, 1), a2 + hstep, voffA);
            PG8_WAIT_V(8); PG8_WAIT_L(0); PG8_BAR; PG8_MMA(0, 0, At, B0); PG8_MMA(0, 1, At, B1); PG8_BAR; PG8_SCHED;
            PG8_LDA(At, 1, 1); PG8_STAGE(PG8_SB(1, 0), b3, voffB); PG8_STAGE(PG8_SB(1, 1), b3 + hstep, voffB); PG8_STAGE(PG8_SA(1, 0), a3, voffA);
            PG8_WAIT_V(8); PG8_WAIT_L(0); PG8_BAR; PG8_MMA(1, 0, At, B0); PG8_MMA(1, 1, At, B1); PG8_BAR; PG8_SCHED;
            } else {
            PG8_LDB(B0, 0, 0); PG8_SCHED; PG8_LDA(At, 0, 0); PG8_STAGE(PG8_SA(1, 1), a1 + hstep, voffA);
            PG8_WAIT_L(8); PG8_BAR; PG8_WAIT_L(0); PG8_MMA(0, 0, At, B0); PG8_BAR; PG8_SCHED;
            PG8_LDB(B1, 0, 1); PG8_STAGE(PG8_SB(0, 0), b2, voffB);
            PG8_BAR; PG8_WAIT_L(0); PG8_MMA(0, 1, At, B1); PG8_BAR;
            PG8_LDA(At, 0, 1); PG8_STAGE(PG8_SA(0, 0), a2, voffA);
            PG8_BAR; PG8_WAIT_L(0); PG8_MMA(1, 0, At, B0); PG8_BAR; PG8_SCHED;
            PG8_STAGE(PG8_SB(0, 1), b2 + hstep, voffB);
            PG8_WAIT_V(6); PG8_BAR; PG8_MMA(1, 1, At, B1); PG8_BAR;
            PG8_LDB(B0, 1, 0); PG8_SCHED; PG8_LDA(At, 1, 0); PG8_STAGE(PG8_SA(0, 1), a2 + hstep, voffA);
            PG8_WAIT_L(8); PG8_BAR; PG8_WAIT_L(0); PG8_MMA(0, 0, At, B0); PG8_BAR; PG8_SCHED;
            PG8_LDB(B1, 1, 1); PG8_STAGE(PG8_SB(1, 0), b3, voffB);
            PG8_BAR; PG8_WAIT_L(0); PG8_MMA(0, 1, At, B1); PG8_BAR;
            PG8_LDA(At, 1, 1); PG8_STAGE(PG8_SA(1, 0), a3, voffA);
            PG8_BAR; PG8_WAIT_L(0); PG8_MMA(1, 0, At, B0); PG8_BAR; PG8_SCHED;
            PG8_STAGE(PG8_SB(1, 1), b3 + hstep, voffB);
            PG8_WAIT_V(6); PG8_BAR; PG8_MMA(1, 1, At, B1); PG8_BAR;
            }
        }
        if constexpr (ALIGN_EPI) { if (wr == 0) PG8_BAR; }
        if constexpr (!Epi::AFTER_DRAIN) { E(acc, cur, wr, wc, fr, fq); S.done(cur); }
        if (!has_next) break;
#pragma unroll
        for (int a = 0; a < 2; ++a)
#pragma unroll
            for (int b = 0; b < 2; ++b)
#pragma unroll
                for (int m = 0; m < 4; ++m)
#pragma unroll
                    for (int n = 0; n < 2; ++n) acc[a][b][m][n] = (f32x4){0.f, 0.f, 0.f, 0.f};
        cur = nxt; cA = nA; cB = nB; ++ui;
        if constexpr (ALIGN_EPI) { if (wr == 1) PG8_BAR; }
    }
    PG8_WAIT_V(0);
    if constexpr (!ALIGN_EPI) { if (wr == 0) PG8_BAR; }
    PG8_BAR;
    if constexpr (Epi::AFTER_DRAIN) { E.fused(acc, cur, wr, wc, fr, fq, lds, wid, lane); S.done(cur); }
#undef PG8_SA
#undef PG8_SB
#undef PG8_STAGE
#undef PG8_LDA
#undef PG8_LDB
#undef PG8_MMA
#undef PG8_WAIT_V
#undef PG8_WAIT_L
#undef PG8_BAR
#undef PG8_SCHED
}
}
#define LAS __attribute__((address_space(3)))
typedef unsigned short bf16;
typedef unsigned v4u __attribute__((ext_vector_type(4)));
typedef unsigned v2u __attribute__((ext_vector_type(2)));
typedef float f32x4 __attribute__((ext_vector_type(4)));
typedef short bf16x8 __attribute__((ext_vector_type(8)));
typedef short s16x4 __attribute__((ext_vector_type(4)));
#define MFMA16(a, b, c) __builtin_amdgcn_mfma_f32_16x16x32_bf16((a), (b), (c), 0, 0, 0)

constexpr int BATCH = 8, SEQ = 8192, D = 1024, M = BATCH * SEQ, NMEM = 256, MMEM = BATCH * NMEM, DIN = 1536, FF = 2816, FF2 = 5632, NH = 4, HD = 256, DEPTH = 2;
constexpr float EPS = 1e-6f;
constexpr size_t MiB = 1u << 20;
constexpr size_t WS_W = 1 * MiB, W_LAYER = 32 * MiB;
constexpr size_t W_IN = 0, W_OUT = 3 * MiB, W_Q = 5 * MiB, W_K = 7 * MiB, W_V = 9 * MiB, W_O = 11 * MiB, W_UP = 13 * MiB, W_DN = 24 * MiB, W_POOL = 30 * MiB, W_SGU = 30 * MiB + 256 * 1024;
constexpr size_t WS_MEMN = 65 * MiB, WS_KB = 69 * MiB, WS_VT = 77 * MiB, WS_SLOTS = 85 * MiB, WS_RAWH = 89 * MiB, WS_HC0 = 101 * MiB, WS_HB = 113 * MiB, WS_BIG = 241 * MiB;
constexpr size_t BIG_PROJ = 0, BIG_YMIX = 24 * MiB, BIG_Q = 24 * MiB, BIG_O = 24 * MiB, BIG_ACT = 0, GAP_P = 20 * MiB / 2, GAP_Y = 28 * MiB / 2, WS_VSTAT = WS_BIG + 352 * MiB  , WS_GT = WS_VSTAT + 4 * MiB  , WS_VWT = WS_GT + 32 * MiB  , WS_END = WS_VWT + 32 * MiB;
constexpr int LDS_BYTES = 147456, HALO_OFF = 139264, MISC_OFF = 136192;
constexpr int KPITCH = 528, PP = 272, VP = 1040, DT_OFF = 40960;

__device__ __forceinline__ unsigned f2bf(float f) { unsigned u = __builtin_bit_cast(unsigned, f); return (u + 0x7fffu + ((u >> 16) & 1u)) >> 16; }
__device__ __forceinline__ unsigned pk2(float lo, float hi) { return f2bf(lo) | (f2bf(hi) << 16); }
__device__ __forceinline__ float bflo(unsigned w) { return __uint_as_float(w << 16); }
__device__ __forceinline__ float bfhi(unsigned w) { return __uint_as_float(w & 0xffff0000u); }
__device__ __forceinline__ float wave_sum(float v) {
#pragma unroll
    for (int o = 1; o < 64; o <<= 1) v += __shfl_xor(v, o);
    return v;
}
#define LDS_WAIT() asm volatile("s_waitcnt lgkmcnt(0)" ::: "memory")

__device__ __forceinline__ void transpose_item(const float* W, int K, int N, const float* gk, bf16* WT, bool up_perm, LAS float* scr, int item, int lane) {
    const int nblk = N / 32, kb = item / nblk, nb = item % nblk, k0 = 64 * kb, n0 = 32 * nb;
#pragma unroll 16
    for (int i = 0; i < 32; ++i) { const int kk = 2 * i + (lane >> 5); float w = __builtin_nontemporal_load(W + (size_t)(k0 + kk) * N + n0 + (lane & 31)); if (gk) w *= gk[k0 + kk]; scr[kk * 33 + (lane & 31)] = w; }
    LDS_WAIT(); asm volatile("" ::: "memory");
    int nrow0 = n0; if (up_perm) { const int bj = n0 / FF, i = n0 % FF; nrow0 = 256 * (i / 128) + 128 * bj + (i % 128); }
    const int c = lane & 7;
#pragma unroll
    for (int j = 0; j < 4; ++j) { const int n = (lane >> 3) + 8 * j; const LAS float* s = scr + (8 * c) * 33 + n;
        v4u o; o.x = pk2(s[0 * 33], s[1 * 33]); o.y = pk2(s[2 * 33], s[3 * 33]); o.z = pk2(s[4 * 33], s[5 * 33]); o.w = pk2(s[6 * 33], s[7 * 33]);
        *(v4u*)(WT + (size_t)(nrow0 + n) * K + k0 + 8 * c) = o; }
    LDS_WAIT(); asm volatile("" ::: "memory");
}

struct Args { const float* in[22]; float* out; unsigned char* ws; };
enum { I_X = 0, I_MEM, I_NMIXG, I_WIN, I_POOLW, I_POOLS, I_SGUG, I_SGUW, I_SGUB, I_WOUT, I_NXG, I_MEMG, I_WQ, I_WK, I_WV, I_WO, I_NFG, I_WUP, I_CONVW, I_CONVB, I_WDN, I_FING };

__device__ __forceinline__ void prologue(const Args& a, LAS unsigned char* lds, int gw, int NGW, int lane, int wave) {
    LAS float* scr = (LAS float*)(lds + wave * 8448);
    unsigned char* ws = a.ws;
    constexpr int N_IN = 16 * 48, N_SQ = 16 * 32, N_UP = 16 * 176, N_DN = 44 * 32, N_POOL = 32, PER_L = N_IN + 5 * N_SQ + N_UP + N_DN + N_POOL;
    for (int it = gw; it < DEPTH * PER_L; it += NGW) {
        const int l = it / PER_L; int r = it % PER_L; unsigned char* wl = ws + WS_W + (size_t)l * W_LAYER;
        if (r < N_IN) { transpose_item(a.in[I_WIN] + (size_t)l * D * DIN, D, DIN, a.in[I_NMIXG] + l * D, (bf16*)(wl + W_IN), false, scr, r, lane); continue; } r -= N_IN;
        if (r < N_SQ) { if (r >= 8 * 32) transpose_item(a.in[I_WOUT] + (size_t)l * D * D, D, D, nullptr, (bf16*)(wl + W_OUT), false, scr, r, lane); continue; } r -= N_SQ;
        if (r < N_SQ) {
#pragma unroll
            for (int i = 0; i < 2; ++i) { const int k = 2 * r + i; const float gk = a.in[I_NXG][l * D + k];
#pragma unroll
                for (int j = 0; j < 2; ++j) { const int c = 8 * lane + 512 * j; const f32x4* src = (const f32x4*)(a.in[I_WQ] + (size_t)l * D * D + (size_t)k * D + c); const f32x4 x0 = __builtin_nontemporal_load(src), x1 = __builtin_nontemporal_load(src + 1);
                    v4u o; o.x = pk2(x0[0] * gk, x0[1] * gk); o.y = pk2(x0[2] * gk, x0[3] * gk); o.z = pk2(x1[0] * gk, x1[1] * gk); o.w = pk2(x1[2] * gk, x1[3] * gk);
                    *(v4u*)((bf16*)(wl + W_Q) + ((size_t)(c >> 8) * D + k) * 256 + (c & 255)) = o; } }
            continue; } r -= N_SQ;
        if (r < N_SQ) { transpose_item(a.in[I_WK] + (size_t)l * D * D, D, D, a.in[I_MEMG] + l * D, (bf16*)(wl + W_K), false, scr, r, lane); continue; } r -= N_SQ;
        if (r < N_SQ) { transpose_item(a.in[I_WV] + (size_t)l * D * D, D, D, a.in[I_MEMG] + l * D, (bf16*)(wl + W_V), false, scr, r, lane); continue; } r -= N_SQ;
        if (r < N_SQ) { const int h = r >> 7;
            transpose_item(a.in[I_WO] + (size_t)l * D * D + (size_t)h * 256 * D, 256, D, nullptr, (bf16*)(wl + W_O) + (size_t)h * D * 256, false, scr, r & 127, lane); continue; } r -= N_SQ;
        if (r < N_UP) { transpose_item(a.in[I_WUP] + (size_t)l * D * FF2, D, FF2, a.in[I_NFG] + l * D, (bf16*)(wl + W_UP), true, scr, r, lane); continue; } r -= N_UP;
        if (r < N_DN) { transpose_item(a.in[I_WDN] + (size_t)l * FF * D, FF, D, nullptr, (bf16*)(wl + W_DN), false, scr, r, lane); continue; } r -= N_DN;
        { const int g = r / 8; transpose_item(a.in[I_POOLW] + (size_t)(l * 4 + g) * 128 * 128, 128, 128, nullptr, (bf16*)(wl + W_POOL) + g * 128 * 128, false, scr, r % 8, lane); }
    }
    for (int wi = gw; wi < DEPTH * 1024; wi += NGW) { const int l = wi >> 10, rem = wi & 1023, kc = rem >> 4, n = (rem & 15) * 64 + lane, g = kc >> 4, c0 = (kc & 15) * 8;
        const float* wo_ = a.in[I_WOUT] + (size_t)l * D * D + (size_t)(g * 128) * D + n; const float* pw = a.in[I_POOLW] + (size_t)(l * 4 + g) * 128 * 128 + c0 * 128; const float* ps = a.in[I_POOLS] + l * 512 + g * 128;
        float acc8[8];
#pragma unroll
        for (int i = 0; i < 8; ++i) acc8[i] = 0.f;
#pragma unroll 16
        for (int dd = 0; dd < 128; ++dd) { const float w = wo_[(size_t)dd * D] * ps[dd];
#pragma unroll
            for (int i = 0; i < 8; ++i) acc8[i] += pw[i * 128 + dd] * w; }
        v4u o; o.x = pk2(acc8[0], acc8[1]); o.y = pk2(acc8[2], acc8[3]); o.z = pk2(acc8[4], acc8[5]); o.w = pk2(acc8[6], acc8[7]);
        *(v4u*)((bf16*)(ws + WS_W + (size_t)l * W_LAYER + W_OUT) + (size_t)n * D + g * 128 + c0) = o; }
    for (int i = gw * 64 + lane; i < DEPTH * 4 * 128 * 128; i += NGW * 64) { const int l = i >> 16, rem = i & 65535, t = (rem >> 7) & 127, s = rem & 127;
        const float w = a.in[I_SGUW][i]; ((bf16*)(ws + WS_W + (size_t)l * W_LAYER + W_SGU))[rem] = (bf16)(s <= t ? f2bf(w) : 0u); }
    bf16* HB = (bf16*)(ws + WS_HB); float* slots = (float*)(ws + WS_SLOTS); bf16* MEMN = (bf16*)(ws + WS_MEMN);
    {
        f32x4 nv[4];
        { const int m = gw; if (m < M + MMEM) { const f32x4* xr = (const f32x4*)((m >= M ? a.in[I_MEM] + (size_t)(m - M) * D : a.in[I_X] + (size_t)m * D)) + lane;
#pragma unroll
            for (int j = 0; j < 4; ++j) nv[j] = __builtin_nontemporal_load(xr + 64 * j); } }
        for (int m = gw; m < M + MMEM; m += NGW) {
            const bool is_mem = m >= M; const int row = is_mem ? m - M : m;
            f32x4 v[4]; float s = 0.f;
#pragma unroll
            for (int j = 0; j < 4; ++j) v[j] = nv[j];
            { const int mn = m + NGW; if (mn < M + MMEM) { const f32x4* xr = (const f32x4*)((mn >= M ? a.in[I_MEM] + (size_t)(mn - M) * D : a.in[I_X] + (size_t)mn * D)) + lane;
#pragma unroll
                for (int j = 0; j < 4; ++j) nv[j] = __builtin_nontemporal_load(xr + 64 * j); } }
#pragma unroll
            for (int j = 0; j < 4; ++j) s += (v[j].x * v[j].x + v[j].y * v[j].y) + (v[j].z * v[j].z + v[j].w * v[j].w);
            s = wave_sum(s);
            float sc = 1.f;
            if (is_mem) sc = __builtin_amdgcn_rsqf(s * (1.0f / D) + EPS);
            else if (lane < 16) slots[(size_t)row * 16 + lane] = lane == 0 ? s : 0.f;
            v2u* o8 = (v2u*)((is_mem ? MEMN : HB) + (size_t)row * D) + lane;
#pragma unroll
            for (int j = 0; j < 4; ++j) { v2u o; o.x = pk2(v[j].x * sc, v[j].y * sc); o.y = pk2(v[j].z * sc, v[j].w * sc); o8[64 * j] = o; }
        }
    }
}

#ifndef REP_POOL
#define REP_POOL 1
#endif
#ifndef REP_SGU
#define REP_SGU 1
#endif
constexpr int MIXW = 13056, VP2 = 80;
__device__ __forceinline__ void pool_load(const bf16* proj, int it, int lane, v4u (&raw)[12]) {
    const int chunk = it >> 4, g = (it >> 2) & 3, rq = it & 3; proj += (size_t)(chunk >> 6) * GAP_P;
    const size_t R0 = (size_t)chunk * 128 + rq * 32; const int tseq = (int)(R0 & (SEQ - 1)), r = lane & 15, q = lane >> 4;
#pragma unroll
    for (int i = 0; i < 12; ++i) { const int row = q + 4 * i; raw[i] = (v4u){0u, 0u, 0u, 0u};
        if (row >= 16 || tseq != 0) raw[i] = __builtin_nontemporal_load((const v4u*)(proj + (R0 + row - 16) * DIN + g * 128 + r * 8)); }
}
__device__ __forceinline__ void pool_item(LAS unsigned char* wl, const bf16* proj, bf16* ymix, const bf16* WpT, const float* pscale, int chunk, int g, int rq, int lane, v4u (&raw)[12], int nxt_it) {
    ymix += (size_t)(chunk >> 6) * GAP_Y;
    const size_t R0 = (size_t)chunk * 128 + rq * 32; const int tseq = (int)(R0 & (SEQ - 1));
    const int r = lane & 15, q = lane >> 4, win = 2 << g;
#pragma unroll
    for (int i = 0; i < 12; ++i) *(LAS v4u*)(wl + (q + 4 * i) * PP + r * 16) = raw[i];
    LDS_WAIT();
    if (nxt_it >= 0) pool_load(proj, nxt_it, lane, raw);
    v4u dv[8];
    {
        float s8[8];
#pragma unroll
        for (int e = 0; e < 8; ++e) s8[e] = 0.f;
        for (int k = 1; k < win; ++k) { const v4u v = *(const LAS v4u*)(wl + (8 * q + 16 - k) * PP + r * 16);
            s8[0] += bflo(v.x); s8[1] += bfhi(v.x); s8[2] += bflo(v.y); s8[3] += bfhi(v.y); s8[4] += bflo(v.z); s8[5] += bfhi(v.z); s8[6] += bflo(v.w); s8[7] += bfhi(v.w); }
#pragma unroll
        for (int i = 0; i < 8; ++i) { const int t = 8 * q + i;
            const v4u cur = *(const LAS v4u*)(wl + (t + 16) * PP + r * 16);
            s8[0] += bflo(cur.x); s8[1] += bfhi(cur.x); s8[2] += bflo(cur.y); s8[3] += bfhi(cur.y); s8[4] += bflo(cur.z); s8[5] += bfhi(cur.z); s8[6] += bflo(cur.w); s8[7] += bfhi(cur.w);
            const int cnt = min(tseq + t + 1, win); const float inv = 1.0f / (float)cnt;
            dv[i].x = pk2(s8[0] * inv - bflo(cur.x), s8[1] * inv - bfhi(cur.x)); dv[i].y = pk2(s8[2] * inv - bflo(cur.y), s8[3] * inv - bfhi(cur.y));
            dv[i].z = pk2(s8[4] * inv - bflo(cur.z), s8[5] * inv - bfhi(cur.z)); dv[i].w = pk2(s8[6] * inv - bflo(cur.w), s8[7] * inv - bfhi(cur.w));
            const v4u old = *(const LAS v4u*)(wl + (t + 16 - (win - 1)) * PP + r * 16);
            s8[0] -= bflo(old.x); s8[1] -= bfhi(old.x); s8[2] -= bflo(old.y); s8[3] -= bfhi(old.y); s8[4] -= bflo(old.z); s8[5] -= bfhi(old.z); s8[6] -= bflo(old.w); s8[7] -= bfhi(old.w); }
    }
#pragma unroll
    for (int i = 0; i < 8; ++i) *(v4u*)(ymix + (R0 + 8 * q + i) * D + g * 128 + r * 8) = dv[i];
    LDS_WAIT();
}
__device__ __forceinline__ void sgu_item(LAS unsigned char* wl, const bf16* proj, bf16* ymix, const float* vstat, const float* sgu_g, const bf16* Wm, const float* sgu_b, int chunk, int h, int lane) {
    proj += (size_t)(chunk >> 6) * GAP_P; ymix += (size_t)(chunk >> 6) * GAP_Y;
    typedef float f32x2 __attribute__((ext_vector_type(2)));
    const size_t R0 = (size_t)chunk * 128;
    const int r = lane & 15, q = lane >> 4, c16 = lane & 3, rsub = lane >> 2;
    LAS f32x2* st = (LAS f32x2*)(wl + 128 * VP2);
#pragma unroll
    for (int hh = 0; hh < 2; ++hh) { const f32x4* sp = (const f32x4*)(vstat + (R0 + lane + 64 * hh) * 16);
        const f32x4 a = sp[0], b = sp[1], c = sp[2], d = sp[3];
        const float s1 = ((a[0] + a[2]) + (b[0] + b[2])) + ((c[0] + c[2]) + (d[0] + d[2])), s2 = ((a[1] + a[3]) + (b[1] + b[3])) + ((c[1] + c[3]) + (d[1] + d[3]));
        const float mean = s1 * (1.0f / 512.0f), var = fmaxf(s2 * (1.0f / 512.0f) - mean * mean, 0.f);
        st[lane + 64 * hh] = (f32x2){mean, __builtin_amdgcn_rsqf(var + EPS)}; }
    bf16x8 wmf[20];
    { const bf16* wm = Wm + (size_t)(h * 128 + r) * 128 + q * 8; int f = 0;
#pragma unroll
      for (int ks = 0; ks < 4; ++ks)
#pragma unroll
        for (int tb = 2 * ks; tb < 8; ++tb) wmf[f++] = *(const bf16x8*)(wm + (size_t)(16 * tb) * 128 + ks * 32); }
    float bias[8];
#pragma unroll
    for (int tb = 0; tb < 8; ++tb) bias[tb] = sgu_b[h * 128 + 16 * tb + r];
    LDS_WAIT();
#pragma unroll 1
    for (int dq = 0; dq < 4; ++dq) {
        const int colv = h * 128 + dq * 32;
        v4u raw[8];
#pragma unroll
        for (int i = 0; i < 8; ++i) raw[i] = __builtin_nontemporal_load((const v4u*)(proj + (R0 + rsub + 16 * i) * DIN + 1024 + colv + c16 * 8));
        const f32x4 g0 = *(const f32x4*)(sgu_g + colv + c16 * 8), g1 = *(const f32x4*)(sgu_g + colv + c16 * 8 + 4);
#pragma unroll
        for (int i = 0; i < 8; ++i) { const int s = rsub + 16 * i; const f32x2 ms = st[s]; const v4u w = raw[i];
            v2u lo, hi; lo.x = pk2((bflo(w.x) - ms.x) * ms.y * g0[0], (bfhi(w.x) - ms.x) * ms.y * g0[1]); lo.y = pk2((bflo(w.y) - ms.x) * ms.y * g0[2], (bfhi(w.y) - ms.x) * ms.y * g0[3]);
            hi.x = pk2((bflo(w.z) - ms.x) * ms.y * g1[0], (bfhi(w.z) - ms.x) * ms.y * g1[1]); hi.y = pk2((bflo(w.w) - ms.x) * ms.y * g1[2], (bfhi(w.w) - ms.x) * ms.y * g1[3]);
            *(LAS v2u*)(wl + s * VP2 + (4 * c16) * 2) = lo; *(LAS v2u*)(wl + s * VP2 + (16 + 4 * c16) * 2) = hi; }
        v4u uu8[8];
#pragma unroll
        for (int tb = 0; tb < 8; ++tb) uu8[tb] = __builtin_nontemporal_load((const v4u*)(proj + (R0 + 16 * tb + r) * DIN + 512 + colv + 8 * q));
        LDS_WAIT();
        v2u olo[8];
#pragma unroll
        for (int n = 0; n < 2; ++n) {
            f32x4 z[8];
#pragma unroll
            for (int tb = 0; tb < 8; ++tb) z[tb] = (f32x4){0.f, 0.f, 0.f, 0.f};
            int f = 0;
#pragma unroll
            for (int ks = 0; ks < 4; ++ks) {
                LAS unsigned char* ad = wl + (ks * 32 + 8 * q + (r >> 2)) * VP2 + (16 * n) * 2 + 8 * (r & 3);
                const s16x4 lo = __builtin_bit_cast(s16x4, __builtin_amdgcn_ds_read_tr16_b64_v4i16((LAS s16x4*)ad));
                const s16x4 hi = __builtin_bit_cast(s16x4, __builtin_amdgcn_ds_read_tr16_b64_v4i16((LAS s16x4*)(ad + 4 * VP2)));
                const bf16x8 vf = __builtin_shufflevector(lo, hi, 0, 1, 2, 3, 4, 5, 6, 7);
#pragma unroll
                for (int tb = 2 * ks; tb < 8; ++tb) z[tb] = MFMA16(vf, wmf[f++], z[tb]);
            }
#pragma unroll
            for (int tb = 0; tb < 8; ++tb) { const v4u uu = uu8[tb]; const unsigned ux = n == 0 ? uu.x : uu.z, uy = n == 0 ? uu.y : uu.w;
                v2u o; o.x = pk2(bflo(ux) * (z[tb][0] + bias[tb]), bfhi(ux) * (z[tb][1] + bias[tb])); o.y = pk2(bflo(uy) * (z[tb][2] + bias[tb]), bfhi(uy) * (z[tb][3] + bias[tb]));
                if (n == 0) olo[tb] = o;
                else { v4u w; w.x = olo[tb].x; w.y = olo[tb].y; w.z = o.x; w.w = o.y; *(v4u*)(ymix + (R0 + 16 * tb + r) * D + 512 + colv + 8 * q) = w; } }
        }
        LDS_WAIT();
    }
}
__device__ __forceinline__ void mixer_phase(LAS unsigned char* lds, const bf16* proj, bf16* ymix, const float* vstat, const bf16* WpT, const float* pscale, const float* sgu_g, const bf16* Wm, const float* sgu_b, int pool_first, int pool_step, int pool_limit, int sgu_first, int sgu_step, int sgu_limit, int tid_in) {
    int tid = tid_in; asm volatile("" : "+v"(tid));
    const int lane = tid & 63, wave = __builtin_amdgcn_readfirstlane(tid >> 6);
    LAS unsigned char* wl = lds + wave * MIXW;
    { v4u raw[12]; if (pool_first < pool_limit) pool_load(proj, pool_first, lane, raw);
      for (int it = pool_first; it < pool_limit; it += pool_step) pool_item(wl, proj, ymix, WpT, pscale, it >> 4, (it >> 2) & 3, it & 3, lane, raw, it + pool_step < pool_limit ? it + pool_step : -1); }
    for (int j = sgu_first; j < sgu_limit; j += sgu_step) sgu_item(wl, proj, ymix, vstat, sgu_g, Wm, sgu_b, j >> 2, j & 3, lane);
}

#define ATT_WAITV_BAR() asm volatile("s_waitcnt vmcnt(0) lgkmcnt(0)\n\ts_barrier" ::: "memory")
#define ATT_LGKM_BAR()  asm volatile("s_waitcnt lgkmcnt(0)\n\ts_barrier" ::: "memory")
#define ATT_SB() __builtin_amdgcn_sched_barrier(0)
#define ATT_NB 8
#define ATT_LDN(f, reg, bt) do { _Pragma("unroll") for (int i_ = 0; i_ < ATT_NB; ++i_) f[i_] = *(const LAS bf16x8*)((reg) + (ATT_NB * (bt) + i_) * 1024 + lane * 16); } while (0)
#define ATT_MMA_S(f, bt, kb0) do { _Pragma("unroll") for (int i_ = 0; i_ < ATT_NB; ++i_) { const int kk_ = (ATT_NB * (bt) + i_) >> 3, st_ = (ATT_NB * (bt) + i_) & 7; \
        s[(kb0) + kk_] = MFMA16(f[i_], qf[st_], s[(kb0) + kk_]); } } while (0)
#define ATT_MMA_O(f, bt, kp0) do { _Pragma("unroll") for (int i_ = 0; i_ < ATT_NB; ++i_) { const int db_ = (ATT_NB * (bt) + i_) >> 2, kk_ = (ATT_NB * (bt) + i_) & 3; \
        o[db_] = MFMA16(f[i_], pf[(kp0) + kk_], o[db_]); } } while (0)
#define ATT_SWEEP(reg, MMA, arg) do { bf16x8 fa_[ATT_NB], fb_[ATT_NB]; ATT_LDN(fa_, reg, 0); \
    _Pragma("unroll") for (int bt_ = 0; bt_ < 64 / ATT_NB; bt_ += 2) { ATT_LDN(fb_, reg, bt_ + 1); ATT_SB(); MMA(fa_, bt_, arg); ATT_SB(); \
        if (bt_ + 2 < 64 / ATT_NB) ATT_LDN(fa_, reg, bt_ + 2); ATT_SB(); MMA(fb_, bt_ + 1, arg); ATT_SB(); } } while (0)
__device__ __forceinline__ void attn_dma_k(LAS unsigned char* reg, const bf16* Kbh, int half, int wave, int lane_in) {
    int lane = lane_in; asm volatile("" : "+v"(lane));
    const int r = lane & 15, qd = lane >> 4, kb = 8 * half + wave;
    const int key = 32 * (kb >> 1) + 8 * (r >> 2) + 4 * (kb & 1) + (r & 3);
    const bf16* g = Kbh + (size_t)key * D + qd * 8;
#pragma unroll
    for (int st = 0; st < 8; ++st) __builtin_amdgcn_global_load_lds((const unsigned*)(g + st * 32), (LAS unsigned*)(reg + (wave * 8 + st) * 1024), 16, 0, 0);
}
__device__ __forceinline__ void attn_dma_v(LAS unsigned char* reg, const bf16* Vbh, int half, int wave, int lane_in) {
    int lane = lane_in; asm volatile("" : "+v"(lane));
    const int r = lane & 15, qd = lane >> 4;
#pragma unroll
    for (int i = 0; i < 8; ++i) { const int db = 2 * wave + (i >> 2), kp = 4 * half + (i & 3);
        __builtin_amdgcn_global_load_lds((const unsigned*)(Vbh + (size_t)(16 * db + r) * MMEM + 32 * kp + 8 * qd), (LAS unsigned*)(reg + (wave * 8 + i) * 1024), 16, 0, 0); }
}
__device__ __forceinline__ void attn_phase(LAS unsigned char* lds, const bf16* Q, const bf16* Kb, const bf16* Vt, bf16* O, int bx, int G, int tid_in) {
    int tid = tid_in; asm volatile("" : "+v"(tid));
    const int lane = tid & 63, wave = __builtin_amdgcn_readfirstlane(tid >> 6);
    LAS unsigned char* R0 = lds; LAS unsigned char* R1 = lds + 65536;
    constexpr int NU = BATCH * NH * (SEQ / 128);
    const int nper = NU / G;
    if (G * nper != NU || (G & 7) || ((G >> 3) * nper) % 4) { return; }
    const int xcd = bx & 7, jw = bx >> 3, tiles_per_pair = (G >> 3) * nper / 4;
#define ATT_DECODE(i_, b_, h_, qt_) do { const int per_pair_ = nper / 4, pi_ = (i_) / per_pair_, t_ = (i_) % per_pair_; const int bh_ = xcd + 8 * pi_; b_ = bh_ >> 2; h_ = bh_ & 3; qt_ = jw * per_pair_ + t_; } while (0)
    (void)tiles_per_pair;
    bf16x8 qf[8]; v2u ost[16]; bf16* ostp = nullptr;
#define ATT_QLOAD(b_, h_, qt_) do { int l2_ = lane; asm volatile("" : "+v"(l2_)); const bf16* qp_ = Q + ((size_t)(b_) * SEQ + (qt_) * 128 + wave * 16 + (l2_ & 15)) * D + (h_) * HD + (l2_ >> 4) * 8; \
        _Pragma("unroll") for (int st_ = 0; st_ < 8; ++st_) qf[st_] = *(const bf16x8*)(qp_ + st_ * 32); } while (0)
    { int b, h, qt; ATT_DECODE(0, b, h, qt); ATT_QLOAD(b, h, qt); const bf16* Kbh = Kb + (size_t)(b * NMEM) * D + h * HD; attn_dma_k(R0, Kbh, 0, wave, lane); attn_dma_k(R1, Kbh, 1, wave, lane); }
    for (int ui = 0; ui < nper; ++ui) {
        int b, h, qt, bn, hn, qtn; ATT_DECODE(ui, b, h, qt); const int uin = ui + 1 < nper ? ui + 1 : ui; ATT_DECODE(uin, bn, hn, qtn);
        const bf16* Vbh = Vt + (size_t)(h * HD) * MMEM + b * NMEM; const bf16* Kbhn = Kb + (size_t)(bn * NMEM) * D + hn * HD;
        asm volatile("s_waitcnt vmcnt(8) lgkmcnt(0)\n\ts_barrier" ::: "memory");
        f32x4 s[16];
#pragma unroll
        for (int kb = 0; kb < 16; ++kb) s[kb] = (f32x4){0.f, 0.f, 0.f, 0.f};
        ATT_SWEEP(R0, ATT_MMA_S, 0);
        ATT_WAITV_BAR();
        if (ostp) {
#pragma unroll
            for (int db = 0; db < 16; ++db) *(v2u*)(ostp + db * 16) = ost[db]; }
        attn_dma_v(R0, Vbh, 0, wave, lane);
        ATT_SWEEP(R1, ATT_MMA_S, 8);
        ATT_WAITV_BAR();
        attn_dma_v(R1, Vbh, 1, wave, lane);
        ATT_QLOAD(bn, hn, qtn);
        float linv; bf16x8 pf[8];
        {
            float mx = -3.0e38f;
#pragma unroll
            for (int kb = 0; kb < 16; ++kb) mx = fmaxf(fmaxf(mx, fmaxf(s[kb][0], s[kb][1])), fmaxf(s[kb][2], s[kb][3]));
            mx = fmaxf(mx, __shfl_xor(mx, 16)); mx = fmaxf(mx, __shfl_xor(mx, 32));
            float sum = 0.f;
#pragma unroll
            for (int kb = 0; kb < 16; ++kb)
#pragma unroll
                for (int j = 0; j < 4; ++j) { const float pz = __builtin_amdgcn_exp2f(s[kb][j] - mx); s[kb][j] = pz; sum += pz; }
            sum += __shfl_xor(sum, 16); sum += __shfl_xor(sum, 32); linv = 1.0f / sum;
#pragma unroll
            for (int kp = 0; kp < 8; ++kp) { v4u w; w.x = pk2(s[2 * kp][0], s[2 * kp][1]); w.y = pk2(s[2 * kp][2], s[2 * kp][3]);
                w.z = pk2(s[2 * kp + 1][0], s[2 * kp + 1][1]); w.w = pk2(s[2 * kp + 1][2], s[2 * kp + 1][3]); pf[kp] = __builtin_bit_cast(bf16x8, w); }
        }
        f32x4 o[16];
#pragma unroll
        for (int db = 0; db < 16; ++db) o[db] = (f32x4){0.f, 0.f, 0.f, 0.f};
        ATT_SWEEP(R0, ATT_MMA_O, 0);
        asm volatile("s_waitcnt vmcnt(8) lgkmcnt(0)\n\ts_barrier" ::: "memory");
        attn_dma_k(R0, Kbhn, 0, wave, lane);
        ATT_SWEEP(R1, ATT_MMA_O, 4);
        ATT_LGKM_BAR();
        attn_dma_k(R1, Kbhn, 1, wave, lane);
        { int l3 = lane; asm volatile("" : "+v"(l3)); ostp = O + ((size_t)b * SEQ + qt * 128 + wave * 16 + (l3 & 15)) * D + h * HD + (l3 >> 4) * 4;
#pragma unroll
          for (int db = 0; db < 16; ++db) { ost[db].x = pk2(o[db][0] * linv, o[db][1] * linv); ost[db].y = pk2(o[db][2] * linv, o[db][3] * linv); } }
    }
#pragma unroll
    for (int db = 0; db < 16; ++db) *(v2u*)(ostp + db * 16) = ost[db];
    ATT_WAITV_BAR();
}

#define XB_TMO      128
#define XB_XCNT(j)  (256  + 64 * (j))
#define XB_XSUB(j)  (1280 + 64 * (j))
#define XB_XGEN(j)  (2304 + 64 * (j))
#define XB_TOP      3328
#define XB_TOPGEN   3392
#define XCD_BAR_WORDS 3456
#define XB_SPIN_CAP (1u << 18)

__device__ __forceinline__ unsigned xb_ld(unsigned* p)              { return __hip_atomic_load(p, __ATOMIC_RELAXED, __HIP_MEMORY_SCOPE_AGENT); }
__device__ __forceinline__ unsigned xb_add(unsigned* p, unsigned v) { return __hip_atomic_fetch_add(p, v, __ATOMIC_RELAXED, __HIP_MEMORY_SCOPE_AGENT); }
__device__ __forceinline__ unsigned xb_xcc_id() { return (unsigned)__builtin_amdgcn_s_getreg((3 << 11) | 20) & 0xFu; }
#define XB_SPIN(cond, bar) do { unsigned _sp = 0; while (cond) { __builtin_amdgcn_s_sleep(1); \
    if ((++_sp & 255u) == 0u) { if (xb_ld(&(bar)[XB_TMO])) break; if (_sp > XB_SPIN_CAP) { atomicAdd(&(bar)[XB_TMO], 1u); break; } } } } while (0)

struct XcdBarrier {
    unsigned* bar; unsigned x;
    volatile LAS unsigned* st;
};

__device__ __forceinline__ XcdBarrier xcd_barrier_post(unsigned* bar, volatile LAS unsigned* st) {
    XcdBarrier b; b.bar = bar; b.x = xb_xcc_id(); b.st = st;
    if (threadIdx.x == 0) (void)xb_add(&bar[XB_XCNT(b.x)], 1u);
    return b;
}
__device__ __forceinline__ void xcd_barrier_complete(unsigned* bar, unsigned x, unsigned& nloc, unsigned& nx) {
    const unsigned G = gridDim.x * gridDim.y * gridDim.z;
    unsigned sum, cnt, mine, sp = 0u;
    for (;;) {
        sum = 0u; cnt = 0u; mine = 0u;
#pragma unroll
        for (unsigned j = 0; j < 16; ++j) { const unsigned c = xb_ld(&bar[XB_XCNT(j)]); sum += c; cnt += (c > 0u) ? 1u : 0u; mine = (j == x) ? c : mine; }
        if (sum == G) break;
        __builtin_amdgcn_s_sleep(1);
        if ((++sp & 255u) == 0u) { if (xb_ld(&bar[XB_TMO])) break; if (sp > XB_SPIN_CAP) { atomicAdd(&bar[XB_TMO], 1u); break; } }
    }
    nloc = mine > 0u ? mine : 1u; nx = cnt > 0u ? cnt : 1u;
}

__device__ __forceinline__ void xcd_barrier(const XcdBarrier& b) {
    asm volatile("s_waitcnt vmcnt(0)" ::: "memory");
    __syncthreads();
    if (threadIdx.x == 0) {
        unsigned* bar = b.bar;
        __builtin_amdgcn_s_waitcnt(0);
        unsigned nloc = b.st[0], nx = b.st[1];
        if (nloc == 0u) { xcd_barrier_complete(bar, b.x, nloc, nx); b.st[0] = nloc; b.st[1] = nx; }
        const unsigned old = xb_add(&bar[XB_XSUB(b.x)], 1u);
        const unsigned gen = old / nloc;
        if (old + 1u == (gen + 1u) * nloc) {
            __builtin_amdgcn_fence(__ATOMIC_RELEASE, "agent");
            asm volatile("s_waitcnt vmcnt(0)" ::: "memory");
            const unsigned og = xb_add(&bar[XB_TOP], 1u);
            const unsigned tg = og / nx;
            if (og + 1u == (tg + 1u) * nx) xb_add(&bar[XB_TOPGEN], 1u);
            else XB_SPIN(xb_ld(&bar[XB_TOPGEN]) == tg, bar);
            __builtin_amdgcn_fence(__ATOMIC_ACQUIRE, "agent");
            xb_add(&bar[XB_XGEN(b.x)], 1u);
            asm volatile("s_waitcnt vmcnt(0)" ::: "memory");
        } else {
            XB_SPIN(xb_ld(&bar[XB_XGEN(b.x)]) == gen, bar);
            __builtin_amdgcn_fence(__ATOMIC_ACQUIRE, "agent");
            asm volatile("s_waitcnt vmcnt(0)" ::: "memory");
        }
    }
    __syncthreads();
}

#define GB_CNT(x)   (4096 + 64 * (x))
#define GB_MISMATCH 4608
#define GB_XCCTAB   8192
#define GB_WORDS    8704
__device__ __forceinline__ void grp_barrier(unsigned* ctl, int grp) {
    asm volatile("s_waitcnt vmcnt(0)" ::: "memory");
    __syncthreads();
    if (threadIdx.x == 0) {
        const unsigned old = xb_add(&ctl[GB_CNT(grp)], 1u), target = (old / 32u + 1u) * 32u;
        XB_SPIN(xb_ld(&ctl[GB_CNT(grp)]) < target, ctl);
        __builtin_amdgcn_fence(__ATOMIC_ACQUIRE, "agent");
        asm volatile("s_waitcnt vmcnt(0)" ::: "memory");
    }
    __syncthreads();
}
#ifndef GEMM_ALIGN
#define GEMM_ALIGN true
#endif
#ifndef GEMM_SP2
#define GEMM_SP2 true
#endif
#ifndef FORCE_SLOW
#define FORCE_SLOW 0
#endif
#ifndef GROUP_SEAMS
#define GROUP_SEAMS 1
#endif
#ifndef REP_PRO
#define REP_PRO 1
#endif
#ifndef UP_STAGGER
#define UP_STAGGER 0
#endif
#ifndef REP_Q
#define REP_Q 1
#endif
#ifndef REP_MIX
#define REP_MIX 1
#endif
#ifndef REP_ATTN
#define REP_ATTN 1
#endif
#ifndef REP_UP
#define REP_UP 1
#endif
#ifndef REP_SYNC
#define REP_SYNC 1
#endif
#ifndef REP_INP
#define REP_INP 1
#endif
#define GRID_SYNC() do { for (int rs_ = 0; rs_ < REP_SYNC; ++rs_) xcd_barrier(xbar); } while (0)
#define SEAM_GRP() do { if (((volatile LAS unsigned*)(lds + MISC_OFF))[2]) grp_barrier((unsigned*)ws, (int)blockIdx.x & 7); else xcd_barrier(xbar); } while (0)
#ifndef SKIP_RES
#define SKIP_RES 0
#endif
#ifndef SKIP_BF
#define SKIP_BF 0
#endif
#ifndef SKIP_KV
#define SKIP_KV 0
#endif
#ifndef SKIP_PRO
#define SKIP_PRO 0
#endif
#ifndef SKIP_UP
#define SKIP_UP 0
#endif
__device__ __forceinline__ int fresh_tid_w(int w) { int t = (w << 6) | hw_lane(); asm volatile("" : "+v"(t)); return t; }
__device__ __forceinline__ unsigned char* fresh_ptr(unsigned char* p) { asm volatile("" : "+s"(p)); return p; }
__global__ void __launch_bounds__(512, 2) fwd_megakernel(Args a) {
    extern __shared__ __attribute__((aligned(16))) unsigned char lds_raw[];
    LAS unsigned char* lds = (LAS unsigned char*)lds_raw;
    cg::grid_group grid = cg::this_grid();
    const int wave_s = __builtin_amdgcn_readfirstlane((int)threadIdx.x >> 6);
#define tid  (fresh_tid_w(wave_s))
#define lane (hw_lane())
#define wave (wave_s)
#define gw   ((int)blockIdx.x * 8 + wave)
    const int G = gridDim.x, bx = blockIdx.x, NGW = G * 8;
#define ws   (fresh_ptr(a.ws))
#define HB   ((bf16*)(ws + WS_HB))
#define slots ((float*)(ws + WS_SLOTS))
#define MEMN ((bf16*)(ws + WS_MEMN))
#define PROJ ((bf16*)(ws + WS_BIG + BIG_PROJ))
#define YMIX ((bf16*)(ws + WS_BIG + BIG_YMIX))
#define QB   ((bf16*)(ws + WS_BIG + BIG_Q))
#define OB   ((bf16*)(ws + WS_BIG + BIG_O))
#define ACT  ((bf16*)(ws + WS_BIG + BIG_ACT))
#define RAWH ((float*)(ws + WS_RAWH))
#define HC0  ((float*)(ws + WS_HC0))
#define VSTAT ((float*)(ws + WS_VSTAT))
    float* hres = a.out;

    unsigned* barw = (unsigned*)ws;
    if (bx == 0) for (int i = tid; i < GB_XCCTAB; i += 512) __hip_atomic_store(barw + i, 0u, __ATOMIC_RELAXED, __HIP_MEMORY_SCOPE_AGENT);
    if (tid == 0) __hip_atomic_store(barw + GB_XCCTAB + bx, xb_xcc_id() + 1u, __ATOMIC_RELAXED, __HIP_MEMORY_SCOPE_AGENT);
    volatile LAS unsigned* bst = (volatile LAS unsigned*)(lds + MISC_OFF);
    if (tid == 0) { bst[0] = 0u; bst[1] = 0u; }
    for (int rp_ = 0; rp_ < REP_PRO; ++rp_) prologue(a, lds, gw, NGW, lane, wave);
    grid.sync();
    const XcdBarrier xbar = xcd_barrier_post(barw, bst);
#define grouped (GROUP_SEAMS && gridDim.x == 256)
#define grp ((int)blockIdx.x & 7)
#define gj  ((int)blockIdx.x >> 3)
    { const int t_ = tid; int mism = 0;
      if (t_ < G && t_ < 512) mism = __hip_atomic_load(barw + GB_XCCTAB + t_, __ATOMIC_RELAXED, __HIP_MEMORY_SCOPE_AGENT) != __hip_atomic_load(barw + GB_XCCTAB + (t_ & 7), __ATOMIC_RELAXED, __HIP_MEMORY_SCOPE_AGENT);
      const int any = __syncthreads_or(mism);
      if (t_ == 0) bst[2] = (grouped && !any && !FORCE_SLOW) ? 1u : 0u;
      __syncthreads(); }

#pragma unroll 1
    for (int i = 0; i < 2 * DEPTH; ++i) { const int l = i >> 1; const bool isv = i & 1; unsigned char* wl = ws + WS_W + (size_t)l * W_LAYER;
        pg8::Gemm g{MEMN, (const bf16*)(wl + (isv ? W_V : W_K)), MMEM, D, D, 0, 0};
        int c_ = (bx + G - 64 * i) % G;
        if (grouped) { const int wg_ = ((grp >> 2) << 4) | ((gj & 3) << 2) | (grp & 3); c_ = (gj < 16 && (gj >> 2) == i) ? ((wg_ & 3) << 3) | (wg_ >> 2) : (1 << 20); }
        pg8::StaticOrder S; S.init(g.M, g.N, G, c_);
        pg8::EpiBf16S E{(bf16*)(ws + (isv ? WS_VT : WS_KB) + (size_t)l * 4 * MiB), 256, (size_t)4 * 65536, (size_t)65536, nullptr, 1.0f, 1 << 30, nullptr, 1 << 30};
        if (!SKIP_KV) pg8::gemm_phase<pg8::EpiBf16S, pg8::StaticOrder, GEMM_ALIGN, GEMM_SP2>(lds, g, S, E, wave_s);
    }

#pragma unroll 1
    for (int l = 0; l < DEPTH; ++l) {
        unsigned char* wl = ws + WS_W + (size_t)l * W_LAYER;
        { pg8::Gemm g{HB, (const bf16*)(wl + W_IN), M, DIN, D}; pg8::StaticOrder S; S.init(M, DIN, G, bx);
          pg8::EpiBf16S E{PROJ, DIN, (size_t)256 * DIN, (size_t)256, slots, 1.0f, 2, VSTAT, 4, GAP_P};
          for (int rep = 0; rep < REP_INP; ++rep) pg8::gemm_phase<pg8::EpiBf16S, pg8::StaticOrder, GEMM_ALIGN, GEMM_SP2>(lds, g, S, E, wave_s); }
        SEAM_GRP();
        if (l == 0) {
#pragma unroll 1
            for (int cq = 0; cq < (grouped ? 2 : DEPTH * 64); ++cq) {
                const int ci = grouped ? (((cq * 8 + (gj >> 2)) >> 2) << 5) | (grp << 2) | ((cq * 8 + (gj >> 2)) & 3) : cq;
                const int l2 = ci >> 6, isvw = (ci >> 5) & 1, bh = ci & 31, b = bh >> 2, h = bh & 3; unsigned char* wl2 = ws + WS_W + (size_t)l2 * W_LAYER;
                const bf16* Khd = (const bf16*)(ws + (isvw ? WS_VT : WS_KB) + (size_t)l2 * 4 * MiB) + (size_t)(b * 4 + h) * 65536;
                const bf16* Whd = (const bf16*)(wl2 + (isvw ? W_O : W_Q)) + (size_t)h * D * 256;
                pg8::Gemm g{isvw ? Whd : Khd, isvw ? Khd : Whd, isvw ? D : 256, isvw ? 256 : D, 256, 0, 0};
                pg8::StaticOrder S; S.init(g.M, g.N, G, grouped ? (gj & 3) : (bx + G - (4 * ci) % G) % G);
                bf16* Od = (bf16*)(ws + (isvw ? WS_VWT : WS_GT) + (size_t)l2 * 16 * MiB + (size_t)b * 2 * MiB) + (isvw ? (size_t)h * 256 : (size_t)h * 256 * D);
                pg8::EpiBf16S E{Od, D, (size_t)256 * D, (size_t)256, nullptr, 1.0f, 1 << 30, nullptr, 1 << 30};
                pg8::gemm_phase<pg8::EpiBf16S, pg8::StaticOrder, GEMM_ALIGN, GEMM_SP2>(lds, g, S, E, wave_s);
            }
        }
        { const int w_ = wave;
          const int pf = grouped ? grp * 1024 + gj * 32 + w_ * 4 : gw, pstep = grouped ? 1 : NGW, plim = grouped ? pf + 4 : (M / 128) * 16;
          const int sf = grouped ? grp * 256 + gj * 8 + w_ : gw, sstep = grouped ? 1 : NGW, slim = grouped ? sf + 1 : (M / 128) * 4;
          for (int rep = 0; rep < REP_MIX; ++rep) mixer_phase(lds, PROJ, YMIX, VSTAT, (const bf16*)(wl + W_POOL), a.in[I_POOLS] + l * 512, a.in[I_SGUG] + l * 512, (const bf16*)(wl + W_SGU), a.in[I_SGUB] + l * 512, pf, pstep, plim, sf, sstep, slim, tid); }
        __syncthreads();
        SEAM_GRP();
        { pg8::Gemm g{YMIX, (const bf16*)(wl + W_OUT), M, D, D, 0, 0, 5, GAP_Y * 2}; pg8::StaticOrder S; S.init(M, D, G, bx);
          pg8::EpiResid E{HB, slots};
          if (!SKIP_RES) pg8::gemm_phase<pg8::EpiResid, pg8::StaticOrder, GEMM_ALIGN, GEMM_SP2>(lds, g, S, E, wave_s); }
        SEAM_GRP();
        { pg8::Gemm g{HB, (const bf16*)(ws + WS_GT + (size_t)l * 16 * MiB), M, D, D, 5, (size_t)2 * MiB}; pg8::StaticOrder S; S.init(M, D, G, bx);
          pg8::EpiSoftmax E{QB, slots, 0.0625f * 1.4426950408889634f, (LAS float*)(lds + HALO_OFF), GAP_Y};
          for (int rep = 0; rep < REP_Q; ++rep) pg8::gemm_phase<pg8::EpiSoftmax, pg8::StaticOrder, true, GEMM_SP2>(lds, g, S, E, wave_s); }
        SEAM_GRP();
        { pg8::Gemm g{QB, (const bf16*)(ws + WS_VWT + (size_t)l * 16 * MiB), M, D, D, 5, (size_t)2 * MiB, 5, GAP_Y * 2}; pg8::StaticOrder S; S.init(M, D, G, bx);
          pg8::EpiResid E{HB, slots};
          if (!SKIP_RES) pg8::gemm_phase<pg8::EpiResid, pg8::StaticOrder, GEMM_ALIGN, GEMM_SP2>(lds, g, S, E, wave_s); }
        SEAM_GRP();
        { pg8::Gemm g{HB, (const bf16*)(wl + W_UP), M, FF2, D}; pg8::StaticOrder S; S.init(M, FF2, G, bx);
          pg8::EpiUpConv E{ACT, slots, a.in[I_CONVW] + (size_t)l * 3 * FF2, a.in[I_CONVB] + (size_t)l * FF2, RAWH, HC0, (LAS float*)(lds + HALO_OFF)};
          if (UP_STAGGER > 0 && ((bx >> 3) & 1)) { for (int i_ = 0; i_ < UP_STAGGER; ++i_) __builtin_amdgcn_s_sleep(127); }
          for (int rep = 0; rep < REP_UP; ++rep) pg8::gemm_phase<pg8::EpiUpConv, pg8::StaticOrder, true, GEMM_SP2>(lds, g, S, E, wave_s); }
        SEAM_GRP();
        { const float* cw = a.in[I_CONVW] + (size_t)l * 3 * FF2; pg8::StaticOrder S; S.init(M, D, G, bx); pg8::Unit uu; const int t_ = tid;
          for (int i = 0; S.next(i, uu); ++i) { const int pm = uu.pm; if ((pm & 31) == 0) continue;
            for (int it = t_; it < 2 * (FF / 4); it += 512) { const int c4 = it % (FF / 4), rr = it / (FF / 4);
              const int col = c4 * 4;
              f32x4 hg = *(const f32x4*)(HC0 + (size_t)(pm * 2 + rr) * FF2 + col), hv = *(const f32x4*)(HC0 + (size_t)(pm * 2 + rr) * FF2 + FF + col);
              const f32x4 x1g = *(const f32x4*)(RAWH + (size_t)((pm - 1) * 2 + 1) * FF2 + col), x1v = *(const f32x4*)(RAWH + (size_t)((pm - 1) * 2 + 1) * FF2 + FF + col);
              const f32x4 x2g = *(const f32x4*)(RAWH + (size_t)((pm - 1) * 2) * FF2 + col), x2v = *(const f32x4*)(RAWH + (size_t)((pm - 1) * 2) * FF2 + FF + col);
              const f32x4 w0g = *(const f32x4*)(cw + col), w0v = *(const f32x4*)(cw + FF + col), w1g = *(const f32x4*)(cw + FF2 + col), w1v = *(const f32x4*)(cw + FF2 + FF + col);
              if (rr == 0) { hg += w0g * x2g + w1g * x1g; hv += w0v * x2v + w1v * x1v; } else { hg += w0g * x1g; hv += w0v * x1v; }
              f32x4 r4;
#pragma unroll
              for (int e = 0; e < 4; ++e) r4[e] = hg[e] * __builtin_amdgcn_rcpf(1.0f + __builtin_amdgcn_exp2f(-1.4426950408889634f * hg[e])) * hv[e];
              v2u w; w.x = pk2(r4[0], r4[1]); w.y = pk2(r4[2], r4[3]);
              *(v2u*)(ACT + (size_t)(pm * 256 + rr) * FF + col) = w; } }
          asm volatile("s_waitcnt vmcnt(0)" ::: "memory"); __syncthreads(); }
        { pg8::Gemm g{ACT, (const bf16*)(wl + W_DN), M, D, FF}; pg8::StaticOrder S; S.init(M, D, G, bx);
          pg8::EpiResid E{HB, slots};
          if (!SKIP_RES) pg8::gemm_phase<pg8::EpiResid, pg8::StaticOrder, GEMM_ALIGN, GEMM_SP2>(lds, g, S, E, wave_s); }
        SEAM_GRP();
    }
    { const float* fg = a.in[I_FING]; const int ln = lane, gw0 = grouped ? grp * SEQ + gj * 256 + wave * 32 : gw, fstep = grouped ? 1 : NGW, flim = grouped ? gw0 + 32 : M;
      v2u nw[4]; float nrs = 0.f;
      if (gw0 < flim) { const v2u* xr = (const v2u*)(HB + (size_t)gw0 * D) + ln; nrs = pg8::row_rstd(slots, gw0);
#pragma unroll
        for (int j = 0; j < 4; ++j) nw[j] = __builtin_nontemporal_load(xr + 64 * j); }
      for (int m = gw0; m < flim; m += fstep) { f32x4* orow = (f32x4*)(hres + (size_t)m * D) + ln;
        v2u w[4]; const float rs = nrs;
#pragma unroll
        for (int j = 0; j < 4; ++j) w[j] = nw[j];
        { const int mn = m + fstep; if (mn < flim) { const v2u* xr = (const v2u*)(HB + (size_t)mn * D) + ln; nrs = pg8::row_rstd(slots, mn);
#pragma unroll
            for (int j = 0; j < 4; ++j) nw[j] = __builtin_nontemporal_load(xr + 64 * j); } }
#pragma unroll
        for (int j = 0; j < 4; ++j) { const f32x4 gg = *((const f32x4*)fg + ln + 64 * j);
            __builtin_nontemporal_store((f32x4){bflo(w[j].x), bfhi(w[j].x), bflo(w[j].y), bfhi(w[j].y)} * rs * gg, orow + 64 * j); } } }
}

#undef tid
#undef lane
#undef wave
#undef gw
#undef grouped
#undef grp
#undef gj
#undef ws
#undef HB
#undef slots
#undef MEMN
#undef PROJ
#undef YMIX
#undef QB
#undef OB
#undef ACT
#undef RAWH
#undef HC0
#undef VSTAT
extern "C" void kernel_launch(void* const* d_in, const int* in_sizes, int n_in, void* d_out, int out_size, void* d_ws, size_t ws_size, hipStream_t stream) {
    static int grid = 0;
    if (grid == 0) {
        if (n_in != 22 || in_sizes[0] != M * D || out_size != M * D || ws_size < WS_END) { fprintf(stderr, "kernel_launch: unexpected shapes (n_in %d, in0 %d, out %d, ws %zu)\n", n_in, n_in > 0 ? in_sizes[0] : -1, out_size, ws_size); grid = -1; return; }
        int dev = 0, cus = 0, per_cu = 0;
        hipGetDevice(&dev); hipDeviceGetAttribute(&cus, hipDeviceAttributeMultiprocessorCount, dev);
        if (hipFuncSetAttribute((const void*)fwd_megakernel, hipFuncAttributeMaxDynamicSharedMemorySize, LDS_BYTES) != hipSuccess) { fprintf(stderr, "kernel_launch: hipFuncSetAttribute failed\n"); grid = -1; return; }
        if (hipOccupancyMaxActiveBlocksPerMultiprocessor(&per_cu, (const void*)fwd_megakernel, 512, LDS_BYTES) != hipSuccess || per_cu < 1) { fprintf(stderr, "kernel_launch: occupancy query says %d\n", per_cu); per_cu = 1; }
        (void)hipGetLastError();
        grid = cus * per_cu;
    }
    if (grid < 0) return;
    Args a{};
    for (int i = 0; i < 22; ++i) a.in[i] = (const float*)d_in[i];
    a.out = (float*)d_out; a.ws = (unsigned char*)d_ws;
    void* args[] = {&a};
    hipError_t e = hipLaunchCooperativeKernel((const void*)fwd_megakernel, dim3(grid), dim3(512), args, LDS_BYTES, stream);
    if (e != hipSuccess) fprintf(stderr, "cooperative launch failed: %s (grid %d)\n", hipGetErrorString(e), grid);
}
```
